# Optimizing an MI355X kernel written in HIP

```python
import jax
import jax.numpy as jnp
from jax import lax
import numpy as np

D_MODEL = 1024
BATCH = 8
SEQ = 2048
DEPTH = 2
DEC_BATCH = 128
DEC_SEQ = 1
PAST_LEN = 16384
PAGE_SIZE = 128

N_EVEN = (DEPTH + 1) // 2
N_ODD = DEPTH // 2
GLA_HEADS = 4
GLA_DV = D_MODEL // 8
GLA_DK = GLA_DV // 2
GLA_RANK = 16
GLA_TAU = 16.0
GLA_CHUNK = 64
GLA_QK = GLA_HEADS * GLA_DK
GLA_V = GLA_HEADS * GLA_DV
SG_HEADS = 4
SG_CHUNK = 128
SG_WIDTH = D_MODEL // 2
SG_DH = SG_WIDTH // SG_HEADS
CONV_WIDTH = D_MODEL // 2
CONV_K = 31
CONV_BUF = CONV_K - 1
POOL_WIDTH = D_MODEL // 2
POOL_WINDOWS = (2, 4, 8, 16)
POOL_GROUPS = 4
POOL_DG = POOL_WIDTH // POOL_GROUPS
POOL_BUF = 15
D_FF = 2816
EPS = 1e-6

EVEN_IN = 2 * GLA_QK + 2 * GLA_V + GLA_RANK + 2 * SG_WIDTH
EVEN_MIX = GLA_V + SG_WIDTH
EVEN_SPLITS = (GLA_QK, 2 * GLA_QK, 2 * GLA_QK + GLA_V, 2 * GLA_QK + 2 * GLA_V,
               2 * GLA_QK + 2 * GLA_V + GLA_RANK, 2 * GLA_QK + 2 * GLA_V + GLA_RANK + SG_WIDTH)
ODD_IN = 2 * CONV_WIDTH + POOL_WIDTH
ODD_MIX = CONV_WIDTH + POOL_WIDTH
ODD_SPLITS = (CONV_WIDTH, 2 * CONV_WIDTH)

kernel_name = 'hybrid_gla_gmlp_conformer_pool_step'


def rmsnorm(x, g):
    xf = x.astype(jnp.float32)
    y = xf * lax.rsqrt(jnp.mean(xf * xf, axis=-1, keepdims=True) + EPS)
    return (y * g.astype(jnp.float32)).astype(x.dtype)


def layernorm(x, g, b):
    xf = x.astype(jnp.float32)
    mu = jnp.mean(xf, axis=-1, keepdims=True)
    xc = xf - mu
    var = jnp.mean(xc * xc, axis=-1, keepdims=True)
    y = xc * lax.rsqrt(var + EPS) * g.astype(jnp.float32) + b.astype(jnp.float32)
    return y.astype(x.dtype)


def swiglu(x, w_in, w_out):
    a, b = jnp.split(x @ w_in, 2, axis=-1)
    return (jax.nn.silu(a) * b) @ w_out


def gla_recurrence(q, k, v, log_a, s0):
    bsz, t = q.shape[0], q.shape[1]
    c = GLA_CHUNK if t % GLA_CHUNK == 0 else t
    n = t // c

    def to_chunks(z):
        return jnp.moveaxis(z.astype(jnp.float32).reshape(bsz, n, c, *z.shape[2:]), 1, 0)

    mask = jnp.tril(jnp.ones((c, c), bool))[None, :, :, None, None]

    def step(s, inp):
        qc, kc, vc, gc = inp
        cum = jnp.cumsum(gc, axis=1)
        o_inter = jnp.einsum('bthk,bhkv->bthv', qc * jnp.exp(cum), s)
        diff = cum[:, :, None] - cum[:, None, :]
        decay = jnp.exp(jnp.where(mask, diff, -jnp.inf))
        scores = jnp.einsum('bthk,bshk,btshk->bhts', qc, kc, decay)
        o_intra = jnp.einsum('bhts,bshv->bthv', scores, vc)
        last = cum[:, -1]
        s_new = jnp.exp(last)[..., None] * s + jnp.einsum(
            'bshk,bshv->bhkv', kc * jnp.exp(last[:, None] - cum), vc)
        return s_new, o_inter + o_intra

    s_fin, o = lax.scan(step, s0.astype(jnp.float32),
                        (to_chunks(q), to_chunks(k), to_chunks(v), to_chunks(log_a)))
    o = jnp.moveaxis(o, 0, 1).reshape(bsz, t, GLA_HEADS, GLA_DV)
    return o, s_fin.astype(s0.dtype)


def even_mixer(h, s0, w_in, w_gate, b_gate, gla_g, sg_ln_g, sg_ln_b, sg_w, sg_b, w_out):
    bsz, t, _ = h.shape
    p = h @ w_in
    q, k, v, r, z, u_sg, v_sg = jnp.split(p, EVEN_SPLITS, axis=-1)
    q = q.reshape(bsz, t, GLA_HEADS, GLA_DK) * (GLA_DK ** -0.5)
    k = k.reshape(bsz, t, GLA_HEADS, GLA_DK)
    v = v.reshape(bsz, t, GLA_HEADS, GLA_DV)
    log_a = jax.nn.log_sigmoid((z @ w_gate + b_gate).astype(jnp.float32)) / GLA_TAU
    log_a = log_a.reshape(bsz, t, GLA_HEADS, GLA_DK)
    o, s_new = gla_recurrence(q, k, v, log_a, s0)
    o = rmsnorm(o, gla_g).reshape(bsz, t, GLA_V).astype(h.dtype)
    out_a = o * jax.nn.silu(r)
    u_sg = jax.nn.gelu(u_sg)
    v_sg = layernorm(jax.nn.gelu(v_sg), sg_ln_g, sg_ln_b)
    c = min(t, SG_CHUNK)
    n = t // c
    w_s = jnp.where(jnp.tril(jnp.ones((c, c), bool))[None], sg_w[:, :c, :c], 0.0).astype(v_sg.dtype)
    vh = v_sg.reshape(bsz, n, c, SG_HEADS, SG_DH)
    mixed = jnp.einsum('hts,bnshd->bnthd', w_s, vh) + jnp.transpose(sg_b[:, :c])[None, None, :, :, None]
    out_b = u_sg * mixed.reshape(bsz, t, SG_WIDTH)
    y = jnp.concatenate([out_a, out_b], axis=-1) @ w_out
    return y, s_new, v_sg[:, t - c:]


def odd_mixer(h, conv_buf, pool_buf, have_past, w_in, conv_w, conv_b, ln_g, ln_b, pool_w, pool_scale, w_out):
    bsz, t, _ = h.shape
    p = h @ w_in
    a, gt, xp = jnp.split(p, ODD_SPLITS, axis=-1)
    glu = a * jax.nn.sigmoid(gt)
    gpad = jnp.concatenate([conv_buf.astype(glu.dtype), glu], axis=1)
    conv = lax.conv_general_dilated(gpad, conv_w[:, None, :].astype(glu.dtype), (1,), 'VALID',
                                    dimension_numbers=('NWC', 'WIO', 'NWC'),
                                    feature_group_count=CONV_WIDTH) + conv_b
    out_c = jax.nn.silu(layernorm(conv, ln_g, ln_b))
    xpad = jnp.concatenate([pool_buf.astype(xp.dtype), xp], axis=1)
    cs = jnp.concatenate([jnp.zeros((bsz, 1, POOL_WIDTH), jnp.float32),
                          jnp.cumsum(xpad.astype(jnp.float32), axis=1)], axis=1)
    valid = jnp.concatenate([jnp.full((POOL_BUF,), 1.0 if have_past else 0.0, jnp.float32),
                             jnp.ones((t,), jnp.float32)])
    cv = jnp.concatenate([jnp.zeros((1,), jnp.float32), jnp.cumsum(valid)])
    hi = POOL_BUF + 1
    groups = []
    for gi, win in enumerate(POOL_WINDOWS):
        lo = hi - win
        chan = slice(gi * POOL_DG, (gi + 1) * POOL_DG)
        tot = cs[:, hi:hi + t, chan] - cs[:, lo:lo + t, chan]
        cnt = cv[hi:hi + t] - cv[lo:lo + t]
        groups.append(tot / cnt[None, :, None])
    pooled = jnp.stack(groups, axis=2) - xp.astype(jnp.float32).reshape(bsz, t, POOL_GROUPS, POOL_DG)
    out_d = jnp.einsum('btgc,gcd->btgd', pooled.astype(xp.dtype), pool_w).reshape(bsz, t, POOL_WIDTH) * pool_scale
    y = jnp.concatenate([out_c, out_d], axis=-1) @ w_out
    return y, gpad[:, -CONV_BUF:], xpad[:, -POOL_BUF:]


def run_trunk(x, st_gla, st_conv, st_pool, have_past, norm_g, ff_in, ff_out,
              ev_w_in, ev_w_gate, ev_b_gate, ev_gla_g, ev_sg_ln_g, ev_sg_ln_b, ev_sg_w, ev_sg_b, ev_w_out,
              od_w_in, od_conv_w, od_conv_b, od_ln_g, od_ln_b, od_pool_w, od_pool_scale, od_w_out, norm_f):
    new_gla, new_sgv, new_conv, new_pool = [], [], [], []
    for layer in range(DEPTH):
        i = layer // 2
        x = x + 0.5 * swiglu(rmsnorm(x, norm_g[layer, 0]), ff_in[layer, 0], ff_out[layer, 0])
        hn = rmsnorm(x, norm_g[layer, 1])
        if layer % 2 == 0:
            mix, s_g, v_rows = even_mixer(hn, st_gla[i], ev_w_in[i], ev_w_gate[i], ev_b_gate[i], ev_gla_g[i],
                                          ev_sg_ln_g[i], ev_sg_ln_b[i], ev_sg_w[i], ev_sg_b[i], ev_w_out[i])
            new_gla.append(s_g)
            new_sgv.append(v_rows)
        else:
            mix, c_buf, p_buf = odd_mixer(hn, st_conv[i], st_pool[i], have_past, od_w_in[i], od_conv_w[i],
                                          od_conv_b[i], od_ln_g[i], od_ln_b[i], od_pool_w[i],
                                          od_pool_scale[i], od_w_out[i])
            new_conv.append(c_buf)
            new_pool.append(p_buf)
        x = x + mix
        x = x + 0.5 * swiglu(rmsnorm(x, norm_g[layer, 2]), ff_in[layer, 1], ff_out[layer, 1])
    y = rmsnorm(x, norm_f)
    return y, jnp.stack(new_gla), jnp.stack(new_sgv), jnp.stack(new_conv), jnp.stack(new_pool)


def setup_inputs(seed: int = 0) -> dict:
    key = jax.random.key(seed)
    ks = jax.random.split(key, 32)
    f32 = jnp.float32

    def nrm(k, shape, scale):
        return jax.random.normal(k, shape, f32) * scale

    return {
        'x_prompt': nrm(ks[0], (BATCH, SEQ, D_MODEL), 1.0),
        'x_sample': nrm(ks[1], (DEC_BATCH, DEC_SEQ, D_MODEL), 1.0),
        'state_gla': nrm(ks[2], (N_EVEN, DEC_BATCH, GLA_HEADS, GLA_DK, GLA_DV), 1.0),
        'state_conv': nrm(ks[3], (N_ODD, DEC_BATCH, CONV_BUF, CONV_WIDTH), 0.5),
        'state_pool': nrm(ks[4], (N_ODD, DEC_BATCH, POOL_BUF, POOL_WIDTH), 1.0),
        'norm_g': 1.0 + nrm(ks[5], (DEPTH, 3, D_MODEL), 0.1),
        'ff_in': nrm(ks[6], (DEPTH, 2, D_MODEL, 2 * D_FF), D_MODEL ** -0.5),
        'ff_out': nrm(ks[7], (DEPTH, 2, D_FF, D_MODEL), D_FF ** -0.5),
        'ev_w_in': nrm(ks[8], (N_EVEN, D_MODEL, EVEN_IN), D_MODEL ** -0.5),
        'ev_w_gate': nrm(ks[9], (N_EVEN, GLA_RANK, GLA_QK), GLA_RANK ** -0.5),
        'ev_b_gate': nrm(ks[10], (N_EVEN, GLA_QK), 0.1),
        'ev_gla_g': 1.0 + nrm(ks[11], (N_EVEN, GLA_HEADS, GLA_DV), 0.1),
        'ev_sg_ln_g': 1.0 + nrm(ks[12], (N_EVEN, SG_WIDTH), 0.1),
        'ev_sg_ln_b': nrm(ks[13], (N_EVEN, SG_WIDTH), 0.02),
        'ev_sg_w': nrm(ks[14], (N_EVEN, SG_HEADS, SG_CHUNK, SG_CHUNK), SG_CHUNK ** -0.5),
        'ev_sg_b': 1.0 + nrm(ks[15], (N_EVEN, SG_HEADS, SG_CHUNK), 0.1),
        'ev_w_out': nrm(ks[16], (N_EVEN, EVEN_MIX, D_MODEL), EVEN_MIX ** -0.5),
        'od_w_in': nrm(ks[17], (N_ODD, D_MODEL, ODD_IN), D_MODEL ** -0.5),
        'od_conv_w': nrm(ks[18], (N_ODD, CONV_K, CONV_WIDTH), CONV_K ** -0.5),
        'od_conv_b': nrm(ks[19], (N_ODD, CONV_WIDTH), 0.02),
        'od_ln_g': 1.0 + nrm(ks[20], (N_ODD, CONV_WIDTH), 0.1),
        'od_ln_b': nrm(ks[21], (N_ODD, CONV_WIDTH), 0.02),
        'od_pool_w': nrm(ks[22], (N_ODD, POOL_GROUPS, POOL_DG, POOL_DG), POOL_DG ** -0.5),
        'od_pool_scale': 1.0 + nrm(ks[23], (N_ODD, POOL_WIDTH), 0.1),
        'od_w_out': nrm(ks[24], (N_ODD, ODD_MIX, D_MODEL), ODD_MIX ** -0.5),
        'norm_f': 1.0 + nrm(ks[25], (D_MODEL,), 0.1),
    }


def reference(x_prompt, x_sample, state_gla, state_conv, state_pool, norm_g, ff_in, ff_out,
              ev_w_in, ev_w_gate, ev_b_gate, ev_gla_g, ev_sg_ln_g, ev_sg_ln_b, ev_sg_w, ev_sg_b, ev_w_out,
              od_w_in, od_conv_w, od_conv_b, od_ln_g, od_ln_b, od_pool_w, od_pool_scale, od_w_out, norm_f):
    weights = (norm_g, ff_in, ff_out, ev_w_in, ev_w_gate, ev_b_gate, ev_gla_g, ev_sg_ln_g, ev_sg_ln_b,
               ev_sg_w, ev_sg_b, ev_w_out, od_w_in, od_conv_w, od_conv_b, od_ln_g, od_ln_b, od_pool_w,
               od_pool_scale, od_w_out, norm_f)
    bp = x_prompt.shape[0]
    zero_gla = jnp.zeros((N_EVEN, bp, GLA_HEADS, GLA_DK, GLA_DV), x_prompt.dtype)
    zero_conv = jnp.zeros((N_ODD, bp, CONV_BUF, CONV_WIDTH), x_prompt.dtype)
    zero_pool = jnp.zeros((N_ODD, bp, POOL_BUF, POOL_WIDTH), x_prompt.dtype)
    y_prompt, gla_prompt, sgv_prompt, conv_prompt, pool_prompt = run_trunk(
        x_prompt, zero_gla, zero_conv, zero_pool, False, *weights)
    y_sample, gla_sample, sgv_sample, conv_sample, pool_sample = run_trunk(
        x_sample, state_gla, state_conv, state_pool, True, *weights)
    return (y_prompt, y_sample, gla_prompt, gla_sample, sgv_prompt, sgv_sample,
            conv_prompt, conv_sample, pool_prompt, pool_sample)
```

```cpp
#include <hip/hip_runtime.h>
#include <hip/hip_cooperative_groups.h>
#include <cstdio>
#include <cstdint>
namespace cg = cooperative_groups;

#define LAS __attribute__((address_space(3)))
typedef unsigned short bf16_t;
typedef short bf16x8 __attribute__((ext_vector_type(8)));
typedef float f32x4 __attribute__((ext_vector_type(4)));
typedef float f32x2 __attribute__((ext_vector_type(2)));
typedef unsigned u32x4 __attribute__((ext_vector_type(4)));
typedef unsigned u32x2 __attribute__((ext_vector_type(2)));

#ifndef MK_MULTI
#define MK_MULTI 0
#endif

constexpr int D = 1024, SEQ = 2048, MP = 16384, NS = 128, MT = 16512, MPAD = 16640, DFF = 2816;
constexpr int EVN = 2816, ODN = 1536, PEV_LD = 2816, POD_LD = 1024;
constexpr float EPS = 1e-6f;
constexpr size_t O_Y = 0, O_GLAP = 16908288, O_GLAS = 17170432, O_SGVP = 21364736, O_SGVS = 21889024,
                 O_CONVP = 21954560, O_CONVS = 22077440, O_POOLP = 24043520, O_POOLS = 24104960;
constexpr size_t WS_WFFIN = 0;
constexpr size_t WS_WFFOUT = WS_WFFIN + 4ull * 11534336;
constexpr size_t WS_WEVIN = WS_WFFOUT + 4ull * 5767168;
constexpr size_t WS_WEVOUT = WS_WEVIN + 5767168;
constexpr size_t WS_WODIN = WS_WEVOUT + 2097152;
constexpr size_t WS_WODOUT = WS_WODIN + 3145728;
constexpr size_t WS_WPOOL = WS_WODOUT + 2097152;
constexpr size_t WS_X = WS_WPOOL + 524288;
constexpr size_t WS_XB = WS_X + 68157440;
constexpr size_t WS_SSQ = WS_XB + 34078720;
constexpr size_t WS_H = WS_SSQ + 1064960;
constexpr size_t WS_Z = WS_H + 93716480;
constexpr size_t WS_MIX = WS_Z + 1064960;
constexpr size_t WS_KV = WS_MIX + 34078720;
constexpr size_t WS_DEC = WS_KV + 33554432;
constexpr size_t WS_BAR = WS_DEC + 262144;
constexpr size_t WS_END = WS_BAR + 16384;
constexpr int LDS_BYTES = 147456;

struct Params {
    const float* in[26];
    float* out;
    unsigned char* ws;
    int ph_lo, ph_hi, dry, pad;
};

typedef __bf16 bf16x2_t __attribute__((ext_vector_type(2)));
__device__ __forceinline__ unsigned cvt_pk_bf16(float lo, float hi) { const f32x2 v = {lo, hi}; const bf16x2_t b = __builtin_convertvector(v, bf16x2_t); return __builtin_bit_cast(unsigned, b); }
__device__ __forceinline__ float bf_lo(unsigned w) { return __uint_as_float(w << 16); }
__device__ __forceinline__ float bf_hi(unsigned w) { return __uint_as_float(w & 0xffff0000u); }
__device__ __forceinline__ float bf1(bf16_t b) { return __uint_as_float(((unsigned)b) << 16); }
__device__ __forceinline__ float wave_sum(float v) {
#pragma unroll
    for (int o = 1; o < 64; o <<= 1) v += __shfl_xor(v, o);
    return v;
}
__device__ __forceinline__ float fsigmoid(float x) { return __builtin_amdgcn_rcpf(1.f + __builtin_amdgcn_exp2f(-1.4426950408889634f * x)); }
__device__ __forceinline__ float fsilu(float x) { return x * fsigmoid(x); }
__device__ __forceinline__ float fgelu(float x) { return x * fsigmoid(1.5957691216057308f * (x + 0.044715f * x * x * x)); }
#define LDS_WAIT() asm volatile("s_waitcnt lgkmcnt(0)" ::: "memory")
__device__ __forceinline__ void st16_wt(void* ptr, u32x4 v) { asm volatile("global_store_dwordx4 %0, %1, off sc1\n\ts_nop 2" :: "v"(ptr), "v"(v) : "memory"); }

namespace pg8 {
constexpr int BM = 256, BK = 64, HALF = 128, HTB = HALF * BK * 2, STAGE_BYTES = 8 * HTB, NXCD = 8, WGM = 8;
__host__ __device__ __forceinline__ int lds_byte(int r, int c) { const int st = (r >> 4) * 2 + (c >> 5), rr = r & 15, cc = c & 31, ob = rr * 64 + cc * 2; return st * 1024 + (ob ^ (((ob >> 9) & 1) << 5)); }
__host__ __device__ __forceinline__ void stage_rc(int b, int& R, int& C) { const int st = b / 1024, sb = b % 1024, swz = sb ^ (((sb >> 9) & 1) << 5); R = (st >> 1) * 16 + swz / 64; C = (st & 1) * 32 + (swz % 64) / 2; }
__host__ __device__ __forceinline__ int perm32(int rho) { const int n = rho >> 4, i = rho & 15; return 8 * (i >> 2) + 4 * n + (i & 3); }
struct Unit { int pm, pn; };
struct Gemm { const bf16_t* A; const bf16_t* Bt; int M, N, K; };
struct StaticOrder {
    int nM, nN, nwg, G, c;
    __host__ __device__ void init(int M, int N, int G_, int c_) { nM = M / BM; nN = N / BM; nwg = nM * nN; G = G_; c = c_; }
    __host__ __device__ bool next(int i, Unit& u) const {
        const long L = (long)i * G + c; if (L >= nwg) return false;
        int wgid = (int)L; { const int q = nwg / NXCD, r = nwg % NXCD, xcd = wgid % NXCD, off = wgid / NXCD; wgid = (xcd < r ? xcd * (q + 1) : r * (q + 1) + (xcd - r) * q) + off; }
        const int nig = WGM * nN, gid = wgid / nig, fm = gid * WGM, gsz = (nM - fm) < WGM ? (nM - fm) : WGM;
        u.pm = fm + ((wgid % nig) % gsz); u.pn = (wgid % nig) / gsz; return true;
    }
};
template <class Epi, bool ALIGN_EPI = true>
__device__ __forceinline__ void gemm_phase(LAS unsigned char* lds, const Gemm g, const StaticOrder& S, const Epi& E) {
    const int tid = threadIdx.x, wid = __builtin_amdgcn_readfirstlane(tid >> 6), lane = tid & 63, wr = wid >> 2, wc = wid & 3, fr = lane & 15, fq = lane >> 4;
    const int K = g.K, nt = K / BK;
    unsigned voffA[2], voffB[2];
#pragma unroll
    for (int i = 0; i < 2; ++i) { int R, C; stage_rc(tid * 16 + i * 8192, R, C); const int Rb = Epi::PERM ? ((R & ~31) + perm32(R & 31)) : R;
        voffA[i] = (unsigned)(R * K + C) * 2u; voffB[i] = (unsigned)(Rb * K + C) * 2u; }
    const size_t kstep = (size_t)(BK * 2);
    const size_t hstep = (size_t)HALF * K * 2;
    const size_t tstep = 2 * hstep;
    const unsigned ldsw = (unsigned)wid * 1024u;
    const int aoff = lds_byte(wr * 64 + fr, fq * 8), boff = lds_byte(wc * 32 + fr, fq * 8);
#define PG8_SA(b, h) (((b) * 2 + (h)) * HTB)
#define PG8_SB(b, h) ((4 + (b) * 2 + (h)) * HTB)
#define PG8_STAGE(bufoff, gbase, voff) do { _Pragma("unroll") for (int _i = 0; _i < 2; ++_i) \
        __builtin_amdgcn_global_load_lds((const unsigned*)((const char*)(gbase) + (voff)[_i]), (LAS unsigned*)(lds + (bufoff) + ldsw + _i * 8192), 16, 0, 0); } while (0)
#define PG8_LDA(dst, b, h) do { _Pragma("unroll") for (int m = 0; m < 4; ++m) _Pragma("unroll") for (int k = 0; k < 2; ++k) dst[m][k] = *(const LAS bf16x8*)(lds + PG8_SA(b, h) + aoff + m * 2048 + k * 1024); } while (0)
#define PG8_LDB(dst, b, h) do { _Pragma("unroll") for (int n = 0; n < 2; ++n) _Pragma("unroll") for (int k = 0; k < 2; ++k) dst[n][k] = *(const LAS bf16x8*)(lds + PG8_SB(b, h) + boff + n * 2048 + k * 1024); } while (0)
#define PG8_MMA(ai, bj, At, Bt) do { __builtin_amdgcn_s_setprio(1); _Pragma("unroll") for (int m = 0; m < 4; ++m) _Pragma("unroll") for (int n = 0; n < 2; ++n) _Pragma("unroll") for (int k = 0; k < 2; ++k) \
        acc[ai][bj][m][n] = __builtin_amdgcn_mfma_f32_16x16x32_bf16(Bt[n][k], At[m][k], acc[ai][bj][m][n], 0, 0, 0); __builtin_amdgcn_s_setprio(0); } while (0)
#define PG8_WAIT_V(n) asm volatile("s_waitcnt vmcnt(" #n ")" ::: "memory")
#define PG8_WAIT_L(n) asm volatile("s_waitcnt lgkmcnt(" #n ")" ::: "memory")
#define PG8_BAR __builtin_amdgcn_s_barrier()
#define PG8_SCHED __builtin_amdgcn_sched_barrier(0)
    Unit cur, nxt; int ui = 0;
    if (!S.next(0, cur)) return;
    LAS float* rl = (LAS float*)(lds + STAGE_BYTES);
    { typename Epi::Raw raw0; E.pre_issue(cur, wr, fr, fq, raw0); E.pre_finish(raw0, rl, wr, wc, fr, fq); }
    f32x4 acc[2][2][4][2];
#pragma unroll
    for (int a = 0; a < 2; ++a)
#pragma unroll
        for (int b = 0; b < 2; ++b)
#pragma unroll
            for (int m = 0; m < 4; ++m)
#pragma unroll
                for (int n = 0; n < 2; ++n) acc[a][b][m][n] = (f32x4){0.f, 0.f, 0.f, 0.f};
    bf16x8 At[4][2], B0[2][2], B1[2][2];
    const char* cA = (const char*)g.A + (size_t)cur.pm * tstep; const char* cB = (const char*)g.Bt + (size_t)cur.pn * tstep;
    PG8_STAGE(PG8_SB(0, 0), cB, voffB); PG8_STAGE(PG8_SB(0, 1), cB + hstep, voffB); PG8_STAGE(PG8_SA(0, 0), cA, voffA); PG8_STAGE(PG8_SA(0, 1), cA + hstep, voffA);
    if (wr == 1) PG8_BAR;
    PG8_WAIT_V(2); PG8_BAR;
    PG8_STAGE(PG8_SB(1, 0), cB + kstep, voffB); PG8_STAGE(PG8_SA(1, 0), cA + kstep, voffA); PG8_STAGE(PG8_SB(1, 1), cB + hstep + kstep, voffB);
    PG8_WAIT_V(6); PG8_BAR;
    for (;;) {
        const bool has_next = S.next(ui + 1, nxt);
        const char* nA = has_next ? (const char*)g.A + (size_t)nxt.pm * tstep : cA; const char* nB = has_next ? (const char*)g.Bt + (size_t)nxt.pn * tstep : cB;
        for (int t = 0; t < nt; t += 2) {
            const bool last = (t == nt - 2);
            const char* a1 = cA + (size_t)(t + 1) * kstep;
            const char* a2 = last ? nA : cA + (size_t)(t + 2) * kstep; const char* b2 = last ? nB : cB + (size_t)(t + 2) * kstep;
            const char* a3 = a2 + kstep; const char* b3 = b2 + kstep;
            PG8_LDB(B0, 0, 0); PG8_LDB(B1, 0, 1); PG8_SCHED; PG8_LDA(At, 0, 0); PG8_STAGE(PG8_SA(1, 1), a1 + hstep, voffA);
            PG8_WAIT_V(8); PG8_WAIT_L(0); PG8_BAR; PG8_MMA(0, 0, At, B0); PG8_MMA(0, 1, At, B1); PG8_BAR; PG8_SCHED;
            PG8_LDA(At, 0, 1); PG8_STAGE(PG8_SB(0, 0), b2, voffB); PG8_STAGE(PG8_SB(0, 1), b2 + hstep, voffB); PG8_STAGE(PG8_SA(0, 0), a2, voffA);
            PG8_WAIT_V(8); PG8_WAIT_L(0); PG8_BAR; PG8_MMA(1, 0, At, B0); PG8_MMA(1, 1, At, B1); PG8_BAR; PG8_SCHED;
            PG8_LDB(B0, 1, 0); PG8_LDB(B1, 1, 1); PG8_SCHED; PG8_LDA(At, 1, 0); PG8_STAGE(PG8_SA(0, 1), a2 + hstep, voffA);
            PG8_WAIT_V(8); PG8_WAIT_L(0); PG8_BAR; PG8_MMA(0, 0, At, B0); PG8_MMA(0, 1, At, B1); PG8_BAR; PG8_SCHED;
            PG8_LDA(At, 1, 1); PG8_STAGE(PG8_SB(1, 0), b3, voffB); PG8_STAGE(PG8_SB(1, 1), b3 + hstep, voffB); PG8_STAGE(PG8_SA(1, 0), a3, voffA);
            PG8_WAIT_V(8); PG8_WAIT_L(0); PG8_BAR; PG8_MMA(1, 0, At, B0); PG8_MMA(1, 1, At, B1); PG8_BAR; PG8_SCHED;
        }
        if constexpr (ALIGN_EPI) { if (wr == 0) PG8_BAR; }
        typename Epi::Raw raw; if (has_next) E.pre_issue(nxt, wr, fr, fq, raw);
        E(acc, cur, wr, wc, fr, fq, rl + (ui & 1) * 256);
        if (has_next) E.pre_finish(raw, rl + ((ui + 1) & 1) * 256, wr, wc, fr, fq);
        if (!has_next) break;
#pragma unroll
        for (int a = 0; a < 2; ++a)
#pragma unroll
            for (int b = 0; b < 2; ++b)
#pragma unroll
                for (int m = 0; m < 4; ++m)
#pragma unroll
                    for (int n = 0; n < 2; ++n) acc[a][b][m][n] = (f32x4){0.f, 0.f, 0.f, 0.f};
        cur = nxt; cA = nA; cB = nB; ++ui;
        if constexpr (ALIGN_EPI) { if (wr == 1) PG8_BAR; }
    }
    PG8_WAIT_V(0);
    if constexpr (!ALIGN_EPI) { if (wr == 0) PG8_BAR; }
    PG8_BAR;
#undef PG8_SA
#undef PG8_SB
#undef PG8_STAGE
#undef PG8_LDA
#undef PG8_LDB
#undef PG8_MMA
#undef PG8_WAIT_V
#undef PG8_WAIT_L
#undef PG8_BAR
#undef PG8_SCHED
}
}
using pg8::Unit;

struct NoRaw {};
struct RstdRaw { f32x4 a, b; };
__device__ __forceinline__ void rstd_issue(const float* ssq, int pm, RstdRaw& r) {
    const float* sp = ssq + ((size_t)pm * 256 + (threadIdx.x >> 1)) * 16 + (threadIdx.x & 1) * 8;
    r.a = *(const f32x4*)sp; r.b = *(const f32x4*)(sp + 4);
}
__device__ __forceinline__ void rstd_finish(const RstdRaw& r, LAS float* dst) {
    float t = ((r.a.x + r.a.y) + (r.a.z + r.a.w)) + ((r.b.x + r.b.y) + (r.b.z + r.b.w));
    t += __shfl_xor(t, 1);
    if ((threadIdx.x & 1) == 0) dst[threadIdx.x >> 1] = rsqrtf(t * (1.f / 1024.f) + EPS);
}
__device__ __forceinline__ void unit_rstd(const float* ssq, int row0, int fq, float (&rs)[2][4]) {
    f32x4 q[2][4];
#pragma unroll
    for (int ai = 0; ai < 2; ++ai)
#pragma unroll
        for (int m = 0; m < 4; ++m) q[ai][m] = *(const f32x4*)(ssq + (size_t)(row0 + ai * 128 + m * 16) * 16 + 4 * fq);
#pragma unroll
    for (int ai = 0; ai < 2; ++ai)
#pragma unroll
        for (int m = 0; m < 4; ++m) { float t = (q[ai][m].x + q[ai][m].y) + (q[ai][m].z + q[ai][m].w); t += __shfl_xor(t, 16); t += __shfl_xor(t, 32); rs[ai][m] = rsqrtf(t * (1.f / 1024.f) + EPS); }
}
__device__ __forceinline__ float row_rstd(const float* ssq, int row) {
    const f32x4* p = (const f32x4*)(ssq + (size_t)row * 16);
    const f32x4 a = p[0], b = p[1], c = p[2], d = p[3];
    const float s = ((a.x + a.y) + (a.z + a.w)) + ((b.x + b.y) + (b.z + b.w)) + ((c.x + c.y) + (c.z + c.w)) + ((d.x + d.y) + (d.z + d.w));
    return rsqrtf(s * (1.f / 1024.f) + EPS);
}
struct EpiFfnIn {
    static constexpr bool PERM = true;
    bf16_t* H; const float* ssq;
    typedef RstdRaw Raw;
    __device__ __forceinline__ void pre_issue(const Unit& u, int wr, int fr, int fq, Raw& r) const { rstd_issue(ssq, u.pm, r); }
    __device__ __forceinline__ void pre_finish(const Raw& r, LAS float* dst, int wr, int wc, int fr, int fq) const { rstd_finish(r, dst); }
    __device__ __forceinline__ void operator()(const f32x4 (&acc)[2][2][4][2], const Unit& u, int wr, int wc, int fr, int fq, const LAS float* rl) const {
        const int row0 = u.pm * 256 + wr * 64 + fr, col0 = u.pn * 128 + wc * 32 + 8 * fq;
        float rsa[2][4];
#pragma unroll
        for (int ai = 0; ai < 2; ++ai)
#pragma unroll
            for (int m = 0; m < 4; ++m) rsa[ai][m] = rl[ai * 128 + wr * 64 + m * 16 + fr];
#pragma unroll
        for (int ai = 0; ai < 2; ++ai)
#pragma unroll
            for (int m = 0; m < 4; ++m) {
                const int row = row0 + ai * 128 + m * 16; const float rs = rsa[ai][m];
                const float cexp = -1.4426950408889634f * rs, rs2 = rs * rs;
                f32x2 A2[4], B2[4], E2[4], H2[4];
#pragma unroll
                for (int n = 0; n < 2; ++n) { const f32x4 a = acc[ai][0][m][n], b = acc[ai][1][m][n];
                    A2[2 * n] = (f32x2){a.x, a.y}; A2[2 * n + 1] = (f32x2){a.z, a.w}; B2[2 * n] = (f32x2){b.x, b.y}; B2[2 * n + 1] = (f32x2){b.z, b.w}; }
#pragma unroll
                for (int q = 0; q < 4; ++q) { const f32x2 t = A2[q] * cexp; E2[q].x = __builtin_amdgcn_exp2f(t.x); E2[q].y = __builtin_amdgcn_exp2f(t.y); }
#pragma unroll
                for (int q = 0; q < 4; ++q) { const f32x2 d = E2[q] + 1.0f; E2[q].x = __builtin_amdgcn_rcpf(d.x); E2[q].y = __builtin_amdgcn_rcpf(d.y); }
#pragma unroll
                for (int q = 0; q < 4; ++q) H2[q] = (A2[q] * B2[q]) * rs2 * E2[q];
                u32x4 w; w.x = cvt_pk_bf16(H2[0].x, H2[0].y); w.y = cvt_pk_bf16(H2[1].x, H2[1].y); w.z = cvt_pk_bf16(H2[2].x, H2[2].y); w.w = cvt_pk_bf16(H2[3].x, H2[3].y);
                st16_wt(H + (size_t)row * DFF + col0, w);
            }
    }
};
template <bool FIRST>
struct EpiResid {
    static constexpr bool PERM = true;
    const float* xin_p; bf16_t* XB; float* ssq; float scale;
    typedef NoRaw Raw;
    __device__ __forceinline__ void pre_issue(const Unit&, int, int, int, Raw&) const {}
    __device__ __forceinline__ void pre_finish(const Raw&, LAS float*, int, int, int, int) const {}
    __device__ __forceinline__ void operator()(const f32x4 (&acc)[2][2][4][2], const Unit& u, int wr, int wc, int fr, int fq, const LAS float*) const {
        const int row0 = u.pm * 256 + wr * 64 + fr, col0 = u.pn * 256 + wc * 32 + 8 * fq;
#pragma unroll
        for (int ai = 0; ai < 2; ++ai) {
            f32x4 r[4][2][2];
#pragma unroll
            for (int m = 0; m < 4; ++m)
#pragma unroll
                for (int bj = 0; bj < 2; ++bj) {
                    const size_t off = (size_t)(row0 + ai * 128 + m * 16) * D + col0 + bj * 128;
                    if (FIRST) { r[m][bj][0] = *(const f32x4*)(xin_p + off); r[m][bj][1] = *(const f32x4*)(xin_p + off + 4); }
                    else { const u32x4 w = *(const u32x4*)(XB + off);
                        r[m][bj][0] = (f32x4){bf_lo(w.x), bf_hi(w.x), bf_lo(w.y), bf_hi(w.y)}; r[m][bj][1] = (f32x4){bf_lo(w.z), bf_hi(w.z), bf_lo(w.w), bf_hi(w.w)}; }
                }
            asm volatile("" ::: "memory");
#pragma unroll
            for (int m = 0; m < 4; ++m) {
                const int row = row0 + ai * 128 + m * 16;
                float sq = 0.f;
#pragma unroll
                for (int bj = 0; bj < 2; ++bj) {
                    const f32x4 o0 = r[m][bj][0] + acc[ai][bj][m][0] * scale, o1 = r[m][bj][1] + acc[ai][bj][m][1] * scale;
                    sq += ((o0.x * o0.x + o0.y * o0.y) + (o0.z * o0.z + o0.w * o0.w)) + ((o1.x * o1.x + o1.y * o1.y) + (o1.z * o1.z + o1.w * o1.w));
                    u32x4 w; w.x = cvt_pk_bf16(o0.x, o0.y); w.y = cvt_pk_bf16(o0.z, o0.w); w.z = cvt_pk_bf16(o1.x, o1.y); w.w = cvt_pk_bf16(o1.z, o1.w);
                    st16_wt(XB + (size_t)row * D + col0 + bj * 128, w);
                }
                sq += __shfl_xor(sq, 16); sq += __shfl_xor(sq, 32);
                if (fq == 0) ssq[(size_t)row * 16 + u.pn * 4 + wc] = sq;
            }
            asm volatile("" ::: "memory");
        }
    }
};
struct EpiEvIn {
    static constexpr bool PERM = true;
    bf16_t* P; float* Z; const float* ssq;
    typedef RstdRaw Raw;
    __device__ __forceinline__ void pre_issue(const Unit& u, int wr, int fr, int fq, Raw& r) const { rstd_issue(ssq, u.pm, r); }
    __device__ __forceinline__ void pre_finish(const Raw& r, LAS float* dst, int wr, int wc, int fr, int fq) const { rstd_finish(r, dst); }
    __device__ __forceinline__ void operator()(const f32x4 (&acc)[2][2][4][2], const Unit& u, int wr, int wc, int fr, int fq, const LAS float* rl) const {
        const int row0 = u.pm * 256 + wr * 64 + fr, col0 = u.pn * 256 + wc * 32 + 8 * fq;
        const int pn = u.pn;
        float rsa[2][4];
#pragma unroll
        for (int ai = 0; ai < 2; ++ai)
#pragma unroll
            for (int m = 0; m < 4; ++m) rsa[ai][m] = rl[ai * 128 + wr * 64 + m * 16 + fr];
#pragma unroll
        for (int ai = 0; ai < 2; ++ai)
#pragma unroll
            for (int m = 0; m < 4; ++m) {
                const int row = row0 + ai * 128 + m * 16; const float rs = rsa[ai][m];
                if (pn == 10) {
                    if (wc == 0 && fq < 2) {
                        *(f32x4*)(Z + (size_t)row * 16 + 8 * fq) = acc[ai][0][m][0] * rs;
                        *(f32x4*)(Z + (size_t)row * 16 + 8 * fq + 4) = acc[ai][0][m][1] * rs;
                    }
                } else {
#pragma unroll
                    for (int bj = 0; bj < 2; ++bj) {
                        f32x2 X2[4];
#pragma unroll
                        for (int n = 0; n < 2; ++n) { const f32x4 a = acc[ai][bj][m][n] * rs; X2[2 * n] = (f32x2){a.x, a.y}; X2[2 * n + 1] = (f32x2){a.z, a.w}; }
                        if (pn == 0) {
#pragma unroll
                            for (int q = 0; q < 4; ++q) X2[q] = X2[q] * 0.125f;
                        } else if (pn >= 4) {
                            f32x2 E2[4];
#pragma unroll
                            for (int q = 0; q < 4; ++q) { f32x2 t = X2[q];
                                if (pn >= 6) t = t * ((t * t) * (0.044715f * 1.5957691216057308f) + 1.5957691216057308f);
                                t = t * (-1.4426950408889634f);
                                E2[q].x = __builtin_amdgcn_exp2f(t.x); E2[q].y = __builtin_amdgcn_exp2f(t.y); }
#pragma unroll
                            for (int q = 0; q < 4; ++q) { const f32x2 d = E2[q] + 1.0f; E2[q].x = __builtin_amdgcn_rcpf(d.x); E2[q].y = __builtin_amdgcn_rcpf(d.y); }
#pragma unroll
                            for (int q = 0; q < 4; ++q) X2[q] = X2[q] * E2[q];
                        }
                        u32x4 w; w.x = cvt_pk_bf16(X2[0].x, X2[0].y); w.y = cvt_pk_bf16(X2[1].x, X2[1].y); w.z = cvt_pk_bf16(X2[2].x, X2[2].y); w.w = cvt_pk_bf16(X2[3].x, X2[3].y);
                        st16_wt(P + (size_t)row * PEV_LD + col0 + bj * 128, w);
                    }
                }
            }
    }
};
struct EpiOdIn {
    static constexpr bool PERM = true;
    bf16_t* P; float* out; const float* ssq;
    typedef RstdRaw Raw;
    __device__ __forceinline__ void pre_issue(const Unit& u, int wr, int fr, int fq, Raw& r) const { rstd_issue(ssq, u.pm, r); }
    __device__ __forceinline__ void pre_finish(const Raw& r, LAS float* dst, int wr, int wc, int fr, int fq) const { rstd_finish(r, dst); }
    __device__ __forceinline__ void operator()(const f32x4 (&acc)[2][2][4][2], const Unit& u, int wr, int wc, int fr, int fq, const LAS float* rl) const {
        const int row0 = u.pm * 256 + wr * 64 + fr;
        const int pn = u.pn;
        float rsa[2][4];
#pragma unroll
        for (int ai = 0; ai < 2; ++ai)
#pragma unroll
            for (int m = 0; m < 4; ++m) rsa[ai][m] = rl[ai * 128 + wr * 64 + m * 16 + fr];
#pragma unroll
        for (int ai = 0; ai < 2; ++ai)
#pragma unroll
            for (int m = 0; m < 4; ++m) {
                const int row = row0 + ai * 128 + m * 16; const float rs = rsa[ai][m];
                const int t = row & 2047, b = row >> 11;
                if (pn < 4) {
                    const int col = pn * 128 + wc * 32 + 8 * fq;
                    float v[8];
                    {
                        const float cexp = -1.4426950408889634f * rs;
                        f32x2 E2[4], V2[4];
#pragma unroll
                        for (int n = 0; n < 2; ++n) { const f32x4 g = acc[ai][1][m][n] * cexp;
                            E2[2 * n].x = __builtin_amdgcn_exp2f(g.x); E2[2 * n].y = __builtin_amdgcn_exp2f(g.y); E2[2 * n + 1].x = __builtin_amdgcn_exp2f(g.z); E2[2 * n + 1].y = __builtin_amdgcn_exp2f(g.w); }
#pragma unroll
                        for (int q = 0; q < 4; ++q) { const f32x2 d = E2[q] + 1.0f; E2[q].x = __builtin_amdgcn_rcpf(d.x); E2[q].y = __builtin_amdgcn_rcpf(d.y); }
#pragma unroll
                        for (int n = 0; n < 2; ++n) { const f32x4 a = acc[ai][0][m][n] * rs; V2[2 * n] = (f32x2){a.x, a.y} * E2[2 * n]; V2[2 * n + 1] = (f32x2){a.z, a.w} * E2[2 * n + 1]; }
#pragma unroll
                        for (int q = 0; q < 4; ++q) { v[2 * q] = V2[q].x; v[2 * q + 1] = V2[q].y; }
                    }
                    u32x4 w; w.x = cvt_pk_bf16(v[0], v[1]); w.y = cvt_pk_bf16(v[2], v[3]); w.z = cvt_pk_bf16(v[4], v[5]); w.w = cvt_pk_bf16(v[6], v[7]);
                    st16_wt(P + (size_t)row * POD_LD + col, w);
                    float* o = nullptr;
                    if (row < MP) { if (t >= SEQ - 30) o = out + O_CONVP + ((size_t)(b * 30 + t - (SEQ - 30))) * 512 + col; }
                    else if (row < MT) o = out + O_CONVS + ((size_t)((row - MP) * 30 + 29)) * 512 + col;
                    if (o) { *(f32x4*)o = (f32x4){v[0], v[1], v[2], v[3]}; *(f32x4*)(o + 4) = (f32x4){v[4], v[5], v[6], v[7]}; }
                } else {
#pragma unroll
                    for (int bj = 0; bj < 2; ++bj) {
                        const int col = (pn - 4) * 256 + bj * 128 + wc * 32 + 8 * fq;
                        const f32x4 v0 = acc[ai][bj][m][0] * rs, v1 = acc[ai][bj][m][1] * rs;
                        u32x4 w; w.x = cvt_pk_bf16(v0.x, v0.y); w.y = cvt_pk_bf16(v0.z, v0.w); w.z = cvt_pk_bf16(v1.x, v1.y); w.w = cvt_pk_bf16(v1.z, v1.w);
                        st16_wt(P + (size_t)row * POD_LD + 512 + col, w);
                        float* o = nullptr;
                        if (row < MP) { if (t >= SEQ - 15) o = out + O_POOLP + ((size_t)(b * 15 + t - (SEQ - 15))) * 512 + col; }
                        else if (row < MT) o = out + O_POOLS + ((size_t)((row - MP) * 15 + 14)) * 512 + col;
                        if (o) { *(f32x4*)o = v0; *(f32x4*)(o + 4) = v1; }
                    }
                }
            }
    }
};
struct EpiPool {
    static constexpr bool PERM = true;
    bf16_t* MIX; const float* scale;
    __device__ __forceinline__ void operator()(const f32x4 (&acc)[2][2][4][2], const Unit& u, int wr, int wc, int fr, int fq) const {
        const int row0 = u.pm * 256 + wr * 64 + fr, col0 = u.pn * 256 + wc * 32 + 8 * fq;
#pragma unroll
        for (int bj = 0; bj < 2; ++bj) {
            const int col = col0 + bj * 128;
            const f32x4 s0 = *(const f32x4*)(scale + col), s1 = *(const f32x4*)(scale + col + 4);
#pragma unroll
            for (int ai = 0; ai < 2; ++ai)
#pragma unroll
                for (int m = 0; m < 4; ++m) {
                    const int row = row0 + ai * 128 + m * 16;
                    const f32x4 v0 = acc[ai][bj][m][0] * s0, v1 = acc[ai][bj][m][1] * s1;
                    u32x4 w; w.x = cvt_pk_bf16(v0.x, v0.y); w.y = cvt_pk_bf16(v0.z, v0.w); w.z = cvt_pk_bf16(v1.x, v1.y); w.w = cvt_pk_bf16(v1.z, v1.w);
                    *(u32x4*)(MIX + (size_t)row * D + 512 + col) = w;
                }
        }
    }
};

__device__ __forceinline__ int colmap(int mode, int n) {
    if (mode == 0) return n;
    if (mode == 1) { const int pn = n >> 8, j = n & 255; return j < 128 ? 128 * pn + j : 2816 + 128 * pn + (j - 128); }
    if (mode == 2) { return n < 1536 ? n : (n < 2560 ? n + 16 : (n < 2576 ? n - 1024 : -1)); }
    if (n < 1024) { const int pn = n >> 8, j = n & 255; return j < 128 ? 128 * pn + j : 512 + 128 * pn + (j - 128); }
    return n;
}
__device__ __forceinline__ void tr_item(const float* W, int ldw, int srccol4, const float* gain, bf16_t* dst, int K, LAS float* scr, int lane) {
    const int kl = lane >> 4, n4 = (lane & 15) * 4;
    f32x4 v[16];
#pragma unroll
    for (int i = 0; i < 16; ++i) { const int kk = 4 * i + kl; v[i] = (srccol4 >= 0) ? *(const f32x4*)(W + (size_t)kk * ldw + srccol4) : (f32x4){0.f, 0.f, 0.f, 0.f}; }
#pragma unroll
    for (int i = 0; i < 16; ++i) { const int kk = 4 * i + kl; f32x4 x = v[i]; if (gain) x *= gain[kk];
        LAS float* d = scr + kk * 65 + n4; d[0] = x.x; d[1] = x.y; d[2] = x.z; d[3] = x.w; }
    LDS_WAIT();
    const int c = lane & 7;
#pragma unroll
    for (int j = 0; j < 8; ++j) { const int n = (lane >> 3) + 8 * j; const LAS float* s = scr + (8 * c) * 65 + n;
        u32x4 o; o.x = cvt_pk_bf16(s[0 * 65], s[1 * 65]); o.y = cvt_pk_bf16(s[2 * 65], s[3 * 65]); o.z = cvt_pk_bf16(s[4 * 65], s[5 * 65]); o.w = cvt_pk_bf16(s[6 * 65], s[7 * 65]);
        st16_wt(dst + (size_t)(n) * K + 8 * c, o); }
    LDS_WAIT();
}
__device__ __forceinline__ void prep_one(const Params& p, int it, LAS float* scr, int lane) {
    const float* norm_g = p.in[5];
    const float* W; int K, Np, ldw, mode; const float* gain = nullptr; bf16_t* Bt; int r = it;
    if (r < 5632) { const int idx = r / 1408; r -= idx * 1408; const int l = idx >> 1, j = idx & 1;
        W = p.in[6] + (size_t)idx * 1024 * 5632; K = 1024; Np = 5632; ldw = 5632; mode = 1; gain = norm_g + (l * 3 + (j ? 2 : 0)) * 1024; Bt = (bf16_t*)(p.ws + WS_WFFIN) + (size_t)idx * 5632 * 1024; }
    else if (r < 8448) { r -= 5632; const int idx = r / 704; r -= idx * 704;
        W = p.in[7] + (size_t)idx * 2816 * 1024; K = 2816; Np = 1024; ldw = 1024; mode = 0; Bt = (bf16_t*)(p.ws + WS_WFFOUT) + (size_t)idx * 1024 * 2816; }
    else if (r < 9152) { r -= 8448; W = p.in[8]; K = 1024; Np = 2816; ldw = 2576; mode = 2; gain = norm_g + 1 * 1024; Bt = (bf16_t*)(p.ws + WS_WEVIN); }
    else if (r < 9408) { r -= 9152; W = p.in[16]; K = 1024; Np = 1024; ldw = 1024; mode = 0; Bt = (bf16_t*)(p.ws + WS_WEVOUT); }
    else if (r < 9792) { r -= 9408; W = p.in[17]; K = 1024; Np = 1536; ldw = 1536; mode = 3; gain = norm_g + 4 * 1024; Bt = (bf16_t*)(p.ws + WS_WODIN); }
    else if (r < 10048) { r -= 9792; W = p.in[24]; K = 1024; Np = 1024; ldw = 1024; mode = 0; Bt = (bf16_t*)(p.ws + WS_WODOUT); }
    else { r -= 10048; W = p.in[22]; K = 512; Np = 512; ldw = 128; mode = 4; Bt = (bf16_t*)(p.ws + WS_WPOOL); }
    const int nblk = Np / 64, kb = r / nblk, nb = r % nblk, k0 = 64 * kb, n0 = 64 * nb;
    int sc; const float* Wp;
    if (mode == 4) { const int gk = k0 >> 7, gn = n0 >> 7; sc = (gk == gn) ? (n0 & 127) + (lane & 15) * 4 : -1; Wp = W + (size_t)gk * 16384 + (size_t)(k0 & 127) * 128; }
    else { sc = colmap(mode, n0 + (lane & 15) * 4); Wp = W + (size_t)k0 * ldw; }
    tr_item(Wp, ldw, sc, gain ? gain + k0 : nullptr, Bt + (size_t)n0 * K + k0, K, scr, lane);
}
__device__ __forceinline__ void prep_range(const Params& p, LAS unsigned char* L, int lo, int hi, int wi, int nw) {
    const int lane = threadIdx.x & 63, wave = threadIdx.x >> 6;
    LAS float* scr = (LAS float*)(L + wave * 16640);
    for (int it = lo + wi; it < hi; it += nw) prep_one(p, it, scr, lane);
}
__device__ __forceinline__ void tail_prep(const Params& p, LAS unsigned char* L, int nwg, int lo1, int hi1, int lo2, int hi2) {
    const int G = gridDim.x, rem = nwg % G, bx = blockIdx.x, wave = threadIdx.x >> 6;
    int wi, nw;
    if (rem == 0) { wi = bx * 8 + wave; nw = G * 8; } else { if (bx < rem) return; wi = (bx - rem) * 8 + wave; nw = (G - rem) * 8; }
    prep_range(p, L, lo1, hi1, wi, nw);
    prep_range(p, L, lo2, hi2, wi, nw);
}
__device__ __forceinline__ void phase_prep(const Params& p, LAS unsigned char* L) {
    const int tid = threadIdx.x, lane = tid & 63, wave = tid >> 6;
    const int gw = blockIdx.x * 8 + wave, NGW = gridDim.x * 8;
    prep_range(p, L, 0, 1408, gw, NGW);
    bf16_t* XB = (bf16_t*)(p.ws + WS_XB); float* ssq = (float*)(p.ws + WS_SSQ);
    for (int row = gw; row < MPAD; row += NGW) {
        float s = 0.f;
        if (row < MT) {
            const float* src = row < MP ? p.in[0] + (size_t)row * D : p.in[1] + (size_t)(row - MP) * D;
            f32x4 xv[4];
#pragma unroll
            for (int j = 0; j < 2; ++j) { xv[2 * j] = *(const f32x4*)(src + 8 * lane + 512 * j); xv[2 * j + 1] = *(const f32x4*)(src + 8 * lane + 512 * j + 4); }
#pragma unroll
            for (int j = 0; j < 2; ++j) { const f32x4 a = xv[2 * j], c = xv[2 * j + 1];
                s += ((a.x * a.x + a.y * a.y) + (a.z * a.z + a.w * a.w)) + ((c.x * c.x + c.y * c.y) + (c.z * c.z + c.w * c.w));
                u32x4 w; w.x = cvt_pk_bf16(a.x, a.y); w.y = cvt_pk_bf16(a.z, a.w); w.z = cvt_pk_bf16(c.x, c.y); w.w = cvt_pk_bf16(c.z, c.w);
                st16_wt(XB + (size_t)row * D + 8 * lane + 512 * j, w); }
            s = wave_sum(s);
        } else {
#pragma unroll
            for (int j = 0; j < 2; ++j) st16_wt(XB + (size_t)row * D + 8 * lane + 512 * j, (u32x4){0u, 0u, 0u, 0u});
        }
        if (lane < 16) ssq[(size_t)row * 16 + lane] = (lane == 0) ? s : 0.f;
    }
}

__device__ __forceinline__ void gla_cum(const Params& p, int h, int t0, LAS float* cum, LAS float* zs, LAS float* wgs, LAS float* bgs, LAS float* seg) {
    const int tid = threadIdx.x;
    const float* zb = (const float*)(p.ws + WS_Z);
    for (int i = tid; i < 1024; i += 512) zs[i] = zb[(size_t)t0 * 16 + i];
    for (int i = tid; i < 1024; i += 512) { const int r = i >> 6, k = i & 63; wgs[i] = p.in[9][r * 256 + h * 64 + k]; }
    if (tid < 64) bgs[tid] = p.in[10][h * 64 + tid];
    __syncthreads();
    const int kk = tid & 63, sg = tid >> 6;
    float wv[16];
#pragma unroll
    for (int r = 0; r < 16; ++r) wv[r] = wgs[r * 64 + kk];
    const float bb = bgs[kk];
    float run = 0.f, loc[8];
#pragma unroll
    for (int i = 0; i < 8; ++i) { const int s = sg * 8 + i; float g = bb;
#pragma unroll
        for (int r = 0; r < 16; ++r) g += zs[s * 16 + r] * wv[r];
        const float la = (fminf(g, 0.f) - __logf(1.f + __expf(-fabsf(g)))) * (1.f / 16.f);
        run += la; loc[i] = run; }
    seg[sg * 64 + kk] = run;
    __syncthreads();
    float off = 0.f;
#pragma unroll
    for (int j = 0; j < 8; ++j) if (j < sg) off += seg[j * 64 + kk];
#pragma unroll
    for (int i = 0; i < 8; ++i) cum[(sg * 8 + i) * 65 + kk] = off + loc[i];
    __syncthreads();
}
__device__ __forceinline__ f32x4 mma16(const LAS bf16_t* A, int pa, const LAS bf16_t* B, int pb, int ksteps, f32x4 acc, int fr, int fq) {
#pragma unroll
    for (int ks = 0; ks < ksteps; ++ks) {
        const bf16x8 a = *(const LAS bf16x8*)(A + fr * pa + ks * 32 + fq * 8);
        const bf16x8 b = *(const LAS bf16x8*)(B + fr * pb + ks * 32 + fq * 8);
        acc = __builtin_amdgcn_mfma_f32_16x16x32_bf16(a, b, acc, 0, 0, 0);
    }
    return acc;
}
constexpr int PT = 72;
__device__ __forceinline__ void stage_vt(const bf16_t* pev, int t0, int h, LAS bf16_t* Vt) {
    for (int i = threadIdx.x; i < 1024; i += 512) { const int sI = i >> 4, c8 = (i & 15) * 8;
        const u32x4 w = *(const u32x4*)(pev + (size_t)(t0 + sI) * PEV_LD + 512 + h * 128 + c8);
        const unsigned ww[4] = {w.x, w.y, w.z, w.w};
#pragma unroll
        for (int j = 0; j < 4; ++j) { Vt[(c8 + 2 * j) * PT + sI] = (bf16_t)(ww[j] & 0xffffu); Vt[(c8 + 2 * j + 1) * PT + sI] = (bf16_t)(ww[j] >> 16); } }
}
__device__ __forceinline__ void gla_a_item(const Params& p, LAS unsigned char* L, int item) {
    const int tid = threadIdx.x, wave = tid >> 6, lane = tid & 63, fr = lane & 15, fq = lane >> 4;
    const int b = item >> 7, h = (item >> 5) & 3, c = item & 31, t0 = b * SEQ + c * 64;
    LAS float* cum = (LAS float*)L; LAS bf16_t* Kt = (LAS bf16_t*)(cum + 4160); LAS bf16_t* Vt = Kt + 64 * PT;
    LAS float* zs = (LAS float*)(Vt + 128 * PT); LAS float* wgs = zs + 1024; LAS float* bgs = wgs + 1024; LAS float* seg = bgs + 64;
    gla_cum(p, h, t0, cum, zs, wgs, bgs, seg);
    const bf16_t* pev = (const bf16_t*)(p.ws + WS_H);
    {
        const int kk = tid & 63, sg = tid >> 6;
        const float last = cum[63 * 65 + kk];
        float* cb = (float*)(p.ws + WS_X) + (size_t)item * 4096;
        float kv[8];
#pragma unroll
        for (int i = 0; i < 8; ++i) { const int sI = sg * 8 + i; const float cm = cum[sI * 65 + kk]; cb[sI * 64 + kk] = cm;
            kv[i] = bf1(pev[(size_t)(t0 + sI) * PEV_LD + 256 + h * 64 + kk]) * __expf(last - cm); }
        u32x4 w; w.x = cvt_pk_bf16(kv[0], kv[1]); w.y = cvt_pk_bf16(kv[2], kv[3]); w.z = cvt_pk_bf16(kv[4], kv[5]); w.w = cvt_pk_bf16(kv[6], kv[7]);
        *(LAS u32x4*)(Kt + kk * PT + sg * 8) = w;
        if (tid < 64) ((float*)(p.ws + WS_DEC))[(size_t)item * 64 + tid] = __expf(last);
    }
    stage_vt(pev, t0, h, Vt);
    __syncthreads();
    float* KV = (float*)(p.ws + WS_KV) + (size_t)item * 8192;
#pragma unroll
    for (int kt = 0; kt < 4; ++kt) {
        const f32x4 acc = mma16(Kt + kt * 16 * PT, PT, Vt + wave * 16 * PT, PT, 2, (f32x4){0.f, 0.f, 0.f, 0.f}, fr, fq);
#pragma unroll
        for (int j = 0; j < 4; ++j) KV[(kt * 16 + fq * 4 + j) * 128 + wave * 16 + fr] = acc[j];
    }
    __syncthreads();
}
__device__ __forceinline__ void gla_scan_item(const Params& p, int item) {
    const int bh = item >> 4, e = (item & 15) * 512 + threadIdx.x, k = e >> 7;
    float* KV = (float*)(p.ws + WS_KV); const float* dec = (const float*)(p.ws + WS_DEC);
    float S = 0.f, kvv[32], dd[32];
#pragma unroll
    for (int c = 0; c < 32; ++c) { const size_t it = (size_t)bh * 32 + c; kvv[c] = KV[it * 8192 + e]; dd[c] = dec[it * 64 + k]; }
    bf16_t* Sb = (bf16_t*)(p.ws + WS_X + (16u << 20));
#pragma unroll
    for (int c = 0; c < 32; ++c) { const size_t it = (size_t)bh * 32 + c; Sb[it * 8192 + e] = (bf16_t)(cvt_pk_bf16(S, 0.f) & 0xffffu); S = dd[c] * S + kvv[c]; }
    p.out[O_GLAP + (size_t)bh * 8192 + e] = S;
}
__device__ __forceinline__ void gla_c_item(const Params& p, LAS unsigned char* L, int item) {
    const int tid = threadIdx.x, wave = tid >> 6, lane = tid & 63, fr = lane & 15, fq = lane >> 4;
    const int b = item >> 7, h = (item >> 5) & 3, c = item & 31, t0 = b * SEQ + c * 64;
    LAS bf16_t* Qs = (LAS bf16_t*)L; LAS bf16_t* Ks = Qs + 64 * PT; LAS bf16_t* Ps = Ks + 64 * PT; LAS bf16_t* Vt = Ps + 64 * PT; LAS bf16_t* St = Vt + 128 * PT;
    LAS float* Os = (LAS float*)Vt;
    const bf16_t* pev = (const bf16_t*)(p.ws + WS_H);
    const int vq8 = tid & 15, tq2 = tid >> 4;
    u32x4 rwv[2];
#pragma unroll
    for (int i = 0; i < 2; ++i) rwv[i] = *(const u32x4*)(pev + (size_t)(t0 + 2 * tq2 + i) * PEV_LD + 1024 + h * 128 + 8 * vq8);
    {
        const int sI = tid & 63, kg = tid >> 6;
        const u32x4 qw = *(const u32x4*)(pev + (size_t)(t0 + sI) * PEV_LD + h * 64 + kg * 8);
        const u32x4 kw = *(const u32x4*)(pev + (size_t)(t0 + sI) * PEV_LD + 256 + h * 64 + kg * 8);
        const float* cb = (const float*)(p.ws + WS_X) + (size_t)item * 4096 + sI * 64 + kg * 8;
        const f32x4 c0 = *(const f32x4*)cb, c1 = *(const f32x4*)(cb + 4);
        const float cm[8] = {c0.x, c0.y, c0.z, c0.w, c1.x, c1.y, c1.z, c1.w};
        const float qv[8] = {bf_lo(qw.x), bf_hi(qw.x), bf_lo(qw.y), bf_hi(qw.y), bf_lo(qw.z), bf_hi(qw.z), bf_lo(qw.w), bf_hi(qw.w)};
        const float kv[8] = {bf_lo(kw.x), bf_hi(kw.x), bf_lo(kw.y), bf_hi(kw.y), bf_lo(kw.z), bf_hi(kw.z), bf_lo(kw.w), bf_hi(kw.w)};
        float qe[8], ke[8];
#pragma unroll
        for (int i = 0; i < 8; ++i) { qe[i] = qv[i] * __expf(cm[i]); ke[i] = kv[i] * __expf(-cm[i]); }
        u32x4 w; w.x = cvt_pk_bf16(qe[0], qe[1]); w.y = cvt_pk_bf16(qe[2], qe[3]); w.z = cvt_pk_bf16(qe[4], qe[5]); w.w = cvt_pk_bf16(qe[6], qe[7]);
        *(LAS u32x4*)(Qs + sI * PT + kg * 8) = w;
        w.x = cvt_pk_bf16(ke[0], ke[1]); w.y = cvt_pk_bf16(ke[2], ke[3]); w.z = cvt_pk_bf16(ke[4], ke[5]); w.w = cvt_pk_bf16(ke[6], ke[7]);
        *(LAS u32x4*)(Ks + sI * PT + kg * 8) = w;
    }
    stage_vt(pev, t0, h, Vt);
    {
        const bf16_t* Sb = (const bf16_t*)(p.ws + WS_X + (16u << 20)) + (size_t)item * 8192;
        for (int i = tid; i < 1024; i += 512) { const int k = i >> 4, v8 = (i & 15) * 8; const u32x4 x = *(const u32x4*)(Sb + k * 128 + v8);
            const unsigned ww[4] = {x.x, x.y, x.z, x.w};
#pragma unroll
            for (int j = 0; j < 4; ++j) { St[(v8 + 2 * j) * PT + k] = (bf16_t)(ww[j] & 0xffffu); St[(v8 + 2 * j + 1) * PT + k] = (bf16_t)(ww[j] >> 16); } }
    }
    __syncthreads();
    {
        const int tt = wave >> 1;
#pragma unroll
        for (int si = 0; si < 2; ++si) { const int st = (wave & 1) * 2 + si;
            const f32x4 acc = mma16(Qs + tt * 16 * PT, PT, Ks + st * 16 * PT, PT, 2, (f32x4){0.f, 0.f, 0.f, 0.f}, fr, fq);
#pragma unroll
            for (int j = 0; j < 4; ++j) { const int t = tt * 16 + fq * 4 + j, sI = st * 16 + fr; const float v = (sI <= t) ? acc[j] : 0.f;
                Ps[t * PT + sI] = (bf16_t)(cvt_pk_bf16(v, 0.f) & 0xffffu); } }
    }
    __syncthreads();
    f32x4 oacc[4];
#pragma unroll
    for (int tt = 0; tt < 4; ++tt) {
        f32x4 a = mma16(Qs + tt * 16 * PT, PT, St + wave * 16 * PT, PT, 2, (f32x4){0.f, 0.f, 0.f, 0.f}, fr, fq);
        oacc[tt] = mma16(Ps + tt * 16 * PT, PT, Vt + wave * 16 * PT, PT, 2, a, fr, fq);
    }
    __syncthreads();
#pragma unroll
    for (int tt = 0; tt < 4; ++tt)
#pragma unroll
        for (int j = 0; j < 4; ++j) Os[(tt * 16 + fq * 4 + j) * 132 + wave * 16 + fr] = oacc[tt][j];
    __syncthreads();
    bf16_t* mix = (bf16_t*)(p.ws + WS_MIX);
    const f32x4 ga = *(const f32x4*)(p.in[11] + h * 128 + 8 * vq8), gb = *(const f32x4*)(p.in[11] + h * 128 + 8 * vq8 + 4);
#pragma unroll
    for (int i = 0; i < 2; ++i) {
        const int t = 2 * tq2 + i;
        const f32x4 a = *(const LAS f32x4*)(Os + t * 132 + 8 * vq8), c = *(const LAS f32x4*)(Os + t * 132 + 8 * vq8 + 4);
        float ss = ((a.x * a.x + a.y * a.y) + (a.z * a.z + a.w * a.w)) + ((c.x * c.x + c.y * c.y) + (c.z * c.z + c.w * c.w));
#pragma unroll
        for (int o = 1; o < 16; o <<= 1) ss += __shfl_xor(ss, o);
        const float rs = rsqrtf(ss * (1.f / 128.f) + EPS);
        const u32x4 rw = rwv[i];
        const f32x4 o0 = a * rs * ga * (f32x4){bf_lo(rw.x), bf_hi(rw.x), bf_lo(rw.y), bf_hi(rw.y)};
        const f32x4 o1 = c * rs * gb * (f32x4){bf_lo(rw.z), bf_hi(rw.z), bf_lo(rw.w), bf_hi(rw.w)};
        u32x4 w; w.x = cvt_pk_bf16(o0.x, o0.y); w.y = cvt_pk_bf16(o0.z, o0.w); w.z = cvt_pk_bf16(o1.x, o1.y); w.w = cvt_pk_bf16(o1.z, o1.w);
        st16_wt(mix + (size_t)(t0 + t) * D + h * 128 + 8 * vq8, w);
    }
    __syncthreads();
}
__device__ __forceinline__ void gla_s_item(const Params& p, LAS unsigned char* L, int item) {
    const int tid = threadIdx.x, seq = item >> 2, h = item & 3, row = MP + seq;
    LAS float* qs = (LAS float*)L; LAS float* ks = qs + 64; LAS float* ds = ks + 64; LAS float* po = ds + 64; LAS float* red = po + 512;
    const bf16_t* pev = (const bf16_t*)(p.ws + WS_H);
    if (tid < 64) {
        const float* z = (const float*)(p.ws + WS_Z) + (size_t)row * 16;
        float g = p.in[10][h * 64 + tid];
#pragma unroll
        for (int r = 0; r < 16; ++r) g += z[r] * p.in[9][r * 256 + h * 64 + tid];
        const float la = (fminf(g, 0.f) - log1pf(__expf(-fabsf(g)))) * (1.f / 16.f);
        ds[tid] = __expf(la);
        qs[tid] = bf1(pev[(size_t)row * PEV_LD + h * 64 + tid]);
        ks[tid] = bf1(pev[(size_t)row * PEV_LD + 256 + h * 64 + tid]);
    }
    __syncthreads();
    const int v = tid & 127, kq = tid >> 7;
    const float vv = bf1(pev[(size_t)row * PEV_LD + 512 + h * 128 + v]);
    const float* S0 = p.in[2] + (size_t)item * 8192; float* S1 = p.out + O_GLAS + (size_t)item * 8192;
    float o = 0.f;
    float s0v[16];
#pragma unroll
    for (int i = 0; i < 16; ++i) s0v[i] = S0[(kq * 16 + i) * 128 + v];
#pragma unroll
    for (int i = 0; i < 16; ++i) { const int k = kq * 16 + i; const float s0 = s0v[i]; const float d = ds[k]; o += qs[k] * d * s0; S1[k * 128 + v] = d * s0 + ks[k] * vv; }
    po[kq * 128 + v] = o;
    __syncthreads();
    float ot = 0.f;
    if (tid < 128) {
        float qk = 0.f;
#pragma unroll 8
        for (int k = 0; k < 64; ++k) qk += qs[k] * ks[k];
        ot = po[v] + po[128 + v] + po[256 + v] + po[384 + v] + qk * vv;
    }
    const float ss = wave_sum(ot * ot);
    if (tid < 128 && (tid & 63) == 0) red[tid >> 6] = ss;
    __syncthreads();
    if (tid < 128) {
        const float rs = rsqrtf((red[0] + red[1]) * (1.f / 128.f) + EPS);
        const float r = bf1(pev[(size_t)row * PEV_LD + 1024 + h * 128 + v]);
        const float ov = ot * rs * p.in[11][h * 128 + v] * r;
        ((bf16_t*)(p.ws + WS_MIX))[(size_t)row * D + h * 128 + v] = (bf16_t)(cvt_pk_bf16(ov, 0.f) & 0xffffu);
    }
    __syncthreads();
}

constexpr int PW = 136;
__device__ __forceinline__ void sg_item(const Params& p, LAS unsigned char* L, int item) {
    const int tid = threadIdx.x, wave = tid >> 6, lane = tid & 63, fr = lane & 15, fq = lane >> 4;
    const int h = item & 3, n = (item >> 2) & 15, b = item >> 6, t0 = b * SEQ + n * 128;
    LAS bf16_t* Wb = (LAS bf16_t*)L; LAS bf16_t* vT = Wb + 128 * PW; LAS float* mu = (LAS float*)(vT + 128 * PW); LAS float* rsd = mu + 128; LAS float* Os = rsd + 128;
    const bf16_t* pev = (const bf16_t*)(p.ws + WS_H);
    u32x4 vw[4], uwv[4]; float bv[4];
    {
        const int d8 = (tid & 15) * 8, sr = tid >> 4, tb = 4 * (tid >> 4);
#pragma unroll
        for (int ps = 0; ps < 4; ++ps) vw[ps] = *(const u32x4*)(pev + (size_t)(t0 + ps * 32 + sr) * PEV_LD + 2048 + h * 128 + d8);
#pragma unroll
        for (int i = 0; i < 4; ++i) { bv[i] = p.in[15][h * 128 + tb + i]; uwv[i] = *(const u32x4*)(pev + (size_t)(t0 + tb + i) * PEV_LD + 1536 + h * 128 + d8); }
    }
    {
        const int q = tid & 3, sI = tid >> 2;
        const bf16_t* src = pev + (size_t)(t0 + sI) * PEV_LD + 2048 + q * 128;
        float sm = 0.f, sq = 0.f;
#pragma unroll 4
        for (int i = 0; i < 16; ++i) { const u32x4 w = *(const u32x4*)(src + 8 * i);
            const float f[8] = {bf_lo(w.x), bf_hi(w.x), bf_lo(w.y), bf_hi(w.y), bf_lo(w.z), bf_hi(w.z), bf_lo(w.w), bf_hi(w.w)};
#pragma unroll
            for (int j = 0; j < 8; ++j) { sm += f[j]; sq += f[j] * f[j]; } }
        sm += __shfl_xor(sm, 1); sm += __shfl_xor(sm, 2); sq += __shfl_xor(sq, 1); sq += __shfl_xor(sq, 2);
        const float mean = sm * (1.f / 512.f), var = fmaxf(sq * (1.f / 512.f) - mean * mean, 0.f);
        if (q == 0) { mu[sI] = mean; rsd[sI] = rsqrtf(var + EPS); }
    }
    for (int i = tid; i < 2048; i += 512) {
        const int t = i >> 4, s8 = (i & 15) * 8;
        const float* wrow = p.in[14] + ((size_t)h * 128 + t) * 128 + s8;
        const f32x4 a = *(const f32x4*)wrow, c = *(const f32x4*)(wrow + 4);
        float f[8] = {a.x, a.y, a.z, a.w, c.x, c.y, c.z, c.w};
#pragma unroll
        for (int j = 0; j < 8; ++j) if (s8 + j > t) f[j] = 0.f;
        u32x4 w; w.x = cvt_pk_bf16(f[0], f[1]); w.y = cvt_pk_bf16(f[2], f[3]); w.z = cvt_pk_bf16(f[4], f[5]); w.w = cvt_pk_bf16(f[6], f[7]);
        *(LAS u32x4*)(Wb + t * PW + s8) = w;
    }
    __syncthreads();
    {
        const int d8 = (tid & 15) * 8, sr = tid >> 4;
        const f32x4 g0 = *(const f32x4*)(p.in[12] + h * 128 + d8), g1 = *(const f32x4*)(p.in[12] + h * 128 + d8 + 4);
        const f32x4 b0 = *(const f32x4*)(p.in[13] + h * 128 + d8), b1 = *(const f32x4*)(p.in[13] + h * 128 + d8 + 4);
#pragma unroll
        for (int ps = 0; ps < 4; ++ps) { const int sI = ps * 32 + sr;
            const u32x4 w = vw[ps];
            const float m = mu[sI], r = rsd[sI];
            const f32x4 x0 = ((f32x4){bf_lo(w.x), bf_hi(w.x), bf_lo(w.y), bf_hi(w.y)} - m) * r * g0 + b0;
            const f32x4 x1 = ((f32x4){bf_lo(w.z), bf_hi(w.z), bf_lo(w.w), bf_hi(w.w)} - m) * r * g1 + b1;
            if (n == 15) { float* o = p.out + O_SGVP + ((size_t)(b * 128 + sI)) * 512 + h * 128 + d8; *(f32x4*)o = x0; *(f32x4*)(o + 4) = x1; }
            const unsigned ww[4] = {cvt_pk_bf16(x0.x, x0.y), cvt_pk_bf16(x0.z, x0.w), cvt_pk_bf16(x1.x, x1.y), cvt_pk_bf16(x1.z, x1.w)};
#pragma unroll
            for (int j = 0; j < 4; ++j) { vT[(d8 + 2 * j) * PW + sI] = (bf16_t)(ww[j] & 0xffffu); vT[(d8 + 2 * j + 1) * PW + sI] = (bf16_t)(ww[j] >> 16); } }
    }
    __syncthreads();
#pragma unroll
    for (int tt = 0; tt < 8; ++tt) {
        const f32x4 acc = mma16(Wb + tt * 16 * PW, PW, vT + wave * 16 * PW, PW, tt / 2 + 1, (f32x4){0.f, 0.f, 0.f, 0.f}, fr, fq);
#pragma unroll
        for (int j = 0; j < 4; ++j) Os[(tt * 16 + fq * 4 + j) * 132 + wave * 16 + fr] = acc[j];
    }
    __syncthreads();
    {
        const int d0 = (tid & 15) * 8, tb = 4 * (tid >> 4);
        bf16_t* mix = (bf16_t*)(p.ws + WS_MIX);
#pragma unroll
        for (int i = 0; i < 4; ++i) { const int t = tb + i; const float bias = bv[i];
            const f32x4 a0 = *(const LAS f32x4*)(Os + t * 132 + d0), a1 = *(const LAS f32x4*)(Os + t * 132 + d0 + 4);
            const u32x4 uw = uwv[i];
            const f32x4 o0 = (a0 + bias) * (f32x4){bf_lo(uw.x), bf_hi(uw.x), bf_lo(uw.y), bf_hi(uw.y)};
            const f32x4 o1 = (a1 + bias) * (f32x4){bf_lo(uw.z), bf_hi(uw.z), bf_lo(uw.w), bf_hi(uw.w)};
            u32x4 w; w.x = cvt_pk_bf16(o0.x, o0.y); w.y = cvt_pk_bf16(o0.z, o0.w); w.z = cvt_pk_bf16(o1.x, o1.y); w.w = cvt_pk_bf16(o1.z, o1.w);
            st16_wt(mix + (size_t)(t0 + t) * D + 512 + h * 128 + d0, w); }
    }
    __syncthreads();
}
__device__ __forceinline__ void sg_s_row(const Params& p, int seq, int lane) {
    const int row = MP + seq, c0 = 8 * lane, h = c0 >> 7;
    const bf16_t* pev = (const bf16_t*)(p.ws + WS_H);
    const u32x4 w = *(const u32x4*)(pev + (size_t)row * PEV_LD + 2048 + c0);
    float f[8] = {bf_lo(w.x), bf_hi(w.x), bf_lo(w.y), bf_hi(w.y), bf_lo(w.z), bf_hi(w.z), bf_lo(w.w), bf_hi(w.w)};
    float sm = 0.f;
#pragma unroll
    for (int j = 0; j < 8; ++j) sm += f[j];
    const float mean = wave_sum(sm) * (1.f / 512.f);
    float sq = 0.f;
#pragma unroll
    for (int j = 0; j < 8; ++j) { f[j] -= mean; sq += f[j] * f[j]; }
    const float rs = rsqrtf(wave_sum(sq) * (1.f / 512.f) + EPS);
    const float w00 = p.in[14][(size_t)h * 16384], b0 = p.in[15][h * 128];
    const u32x4 uw = *(const u32x4*)(pev + (size_t)row * PEV_LD + 1536 + c0);
    const float uf[8] = {bf_lo(uw.x), bf_hi(uw.x), bf_lo(uw.y), bf_hi(uw.y), bf_lo(uw.z), bf_hi(uw.z), bf_lo(uw.w), bf_hi(uw.w)};
    float vnv[8], ov[8];
#pragma unroll
    for (int j = 0; j < 8; ++j) { vnv[j] = f[j] * rs * p.in[12][c0 + j] + p.in[13][c0 + j]; ov[j] = uf[j] * (w00 * vnv[j] + b0); }
    float* so = p.out + O_SGVS + (size_t)seq * 512 + c0;
    *(f32x4*)so = (f32x4){vnv[0], vnv[1], vnv[2], vnv[3]}; *(f32x4*)(so + 4) = (f32x4){vnv[4], vnv[5], vnv[6], vnv[7]};
    u32x4 o; o.x = cvt_pk_bf16(ov[0], ov[1]); o.y = cvt_pk_bf16(ov[2], ov[3]); o.z = cvt_pk_bf16(ov[4], ov[5]); o.w = cvt_pk_bf16(ov[6], ov[7]);
    st16_wt((bf16_t*)(p.ws + WS_MIX) + (size_t)row * D + 512 + c0, o);
}

__device__ __forceinline__ void conv_ln_rows(const Params& p, const LAS float* cout, int ntok, int rowbase, int wave, int lane) {
    const int c0 = 8 * lane;
    const f32x4 g0 = *(const f32x4*)(p.in[20] + c0), g1 = *(const f32x4*)(p.in[20] + c0 + 4);
    const f32x4 b0 = *(const f32x4*)(p.in[21] + c0), b1 = *(const f32x4*)(p.in[21] + c0 + 4);
#pragma unroll 4
    for (int t = wave; t < ntok; t += 8) {
        f32x4 x0 = *(const LAS f32x4*)(cout + t * 512 + c0), x1 = *(const LAS f32x4*)(cout + t * 512 + c0 + 4);
        float sm = (x0.x + x0.y) + (x0.z + x0.w) + (x1.x + x1.y) + (x1.z + x1.w);
        float sq = (x0.x * x0.x + x0.y * x0.y) + (x0.z * x0.z + x0.w * x0.w) + (x1.x * x1.x + x1.y * x1.y) + (x1.z * x1.z + x1.w * x1.w);
#pragma unroll
        for (int o = 1; o < 64; o <<= 1) { sm += __shfl_xor(sm, o); sq += __shfl_xor(sq, o); }
        const float mean = sm * (1.f / 512.f), var = fmaxf(sq * (1.f / 512.f) - mean * mean, 0.f);
        const float rs = rsqrtf(var + EPS);
        x0 = (x0 - mean) * rs * g0 + b0; x1 = (x1 - mean) * rs * g1 + b1;
        u32x4 w; w.x = cvt_pk_bf16(fsilu(x0.x), fsilu(x0.y)); w.y = cvt_pk_bf16(fsilu(x0.z), fsilu(x0.w)); w.z = cvt_pk_bf16(fsilu(x1.x), fsilu(x1.y)); w.w = cvt_pk_bf16(fsilu(x1.z), fsilu(x1.w));
        st16_wt((bf16_t*)(p.ws + WS_MIX) + (size_t)(rowbase + t) * D + c0, w);
    }
}
__device__ __forceinline__ void conv_item(const Params& p, LAS unsigned char* L, int item) {
    const int tid = threadIdx.x, b = item >> 6, tb = (item & 63) * 32;
    LAS unsigned* gin = (LAS unsigned*)L;
    LAS float* cout = (LAS float*)(L + 63488);
    const bf16_t* pod = (const bf16_t*)(p.ws + WS_H);
    {
        u32x4 wst[8];
#pragma unroll
        for (int k = 0; k < 8; ++k) { const int i = tid + 512 * k, r = i >> 6, c8 = (i & 63) * 8, t = tb - 30 + r;
            wst[k] = (u32x4){0u, 0u, 0u, 0u};
            if (i < 62 * 64 && t >= 0) wst[k] = *(const u32x4*)(pod + (size_t)(b * SEQ + t) * POD_LD + c8); }
#pragma unroll
        for (int k = 0; k < 8; ++k) { const int i = tid + 512 * k, r = i >> 6, c8 = (i & 63) * 8;
            if (i < 62 * 64) *(LAS u32x4*)(gin + r * 256 + (c8 >> 1)) = wst[k]; }
    }
    const int cp = tid & 255, half = tid >> 8;
    f32x2 w[31];
#pragma unroll
    for (int j = 0; j < 31; ++j) w[j] = *(const f32x2*)(p.in[18] + j * 512 + 2 * cp);
    const f32x2 bias = *(const f32x2*)(p.in[19] + 2 * cp);
    __syncthreads();
#pragma unroll 1
    for (int g = 0; g < 4; ++g) {
        const int tt = half * 16 + g * 4;
        f32x2 a[4];
#pragma unroll
        for (int i = 0; i < 4; ++i) a[i] = bias;
#pragma unroll
        for (int jj = 0; jj < 34; ++jj) { const unsigned x = gin[(tt + jj) * 256 + cp]; const f32x2 xv = (f32x2){bf_lo(x), bf_hi(x)};
#pragma unroll
            for (int i = 0; i < 4; ++i) { const int j = jj - i; if (j >= 0 && j <= 30) a[i] += w[j] * xv; } }
#pragma unroll
        for (int i = 0; i < 4; ++i) *(LAS f32x2*)(cout + (tt + i) * 512 + 2 * cp) = a[i];
    }
    __syncthreads();
    conv_ln_rows(p, cout, 32, b * SEQ + tb, tid >> 6, tid & 63);
    __syncthreads();
}
__device__ __forceinline__ void conv_s_item(const Params& p, LAS unsigned char* L, int seq) {
    const int c = threadIdx.x;
    LAS float* cout = (LAS float*)L;
    const bf16_t* pod = (const bf16_t*)(p.ws + WS_H);
    const float* st = p.in[3] + (size_t)seq * 30 * 512 + c; float* so = p.out + O_CONVS + (size_t)seq * 30 * 512 + c;
    float xs[30], wv[31];
#pragma unroll
    for (int j = 0; j < 30; ++j) { xs[j] = st[j * 512]; wv[j] = p.in[18][j * 512 + c]; }
    wv[30] = p.in[18][30 * 512 + c];
    float a = p.in[19][c] + wv[30] * bf1(pod[(size_t)(MP + seq) * POD_LD + c]);
#pragma unroll
    for (int j = 0; j < 30; ++j) a += wv[j] * xs[j];
#pragma unroll
    for (int j = 1; j < 30; ++j) so[(j - 1) * 512] = xs[j];
    cout[c] = a;
    __syncthreads();
    conv_ln_rows(p, cout, 1, MP + seq, threadIdx.x >> 6, threadIdx.x & 63);
    __syncthreads();
}
constexpr int PP = 520;
struct PoolB { bf16x8 b[4][4]; float sc[4]; };
__device__ __forceinline__ void pool_loadb(const Params& p, PoolB& B) {
    const int tid = threadIdx.x, wave = tid >> 6, lane = tid & 63, fr = lane & 15, fq = lane >> 4, g = wave >> 1;
    const bf16_t* Wp = (const bf16_t*)(p.ws + WS_WPOOL);
#pragma unroll
    for (int dt = 0; dt < 4; ++dt) { const int col = wave * 64 + dt * 16 + fr; B.sc[dt] = p.in[23][col];
#pragma unroll
        for (int ks = 0; ks < 4; ++ks) B.b[dt][ks] = *(const bf16x8*)(Wp + (size_t)col * 512 + g * 128 + ks * 32 + fq * 8); }
}
template <int NT>
__device__ __forceinline__ void pool_mma(const Params& p, const PoolB& B, const LAS bf16_t* Pd, LAS bf16_t* Ob, int rowbase) {
    const int tid = threadIdx.x, wave = tid >> 6, lane = tid & 63, fr = lane & 15, fq = lane >> 4, g = wave >> 1;
#pragma unroll
    for (int dt = 0; dt < 4; ++dt) {
        const int col = wave * 64 + dt * 16 + fr;
#pragma unroll
        for (int tt = 0; tt < NT / 16; ++tt) {
            f32x4 acc = (f32x4){0.f, 0.f, 0.f, 0.f};
#pragma unroll
            for (int ks = 0; ks < 4; ++ks) { const bf16x8 a = *(const LAS bf16x8*)(Pd + (tt * 16 + fr) * PP + g * 128 + ks * 32 + fq * 8);
                acc = __builtin_amdgcn_mfma_f32_16x16x32_bf16(a, B.b[dt][ks], acc, 0, 0, 0); }
            const unsigned w0 = cvt_pk_bf16(acc[0] * B.sc[dt], acc[1] * B.sc[dt]), w1 = cvt_pk_bf16(acc[2] * B.sc[dt], acc[3] * B.sc[dt]);
            LAS bf16_t* o = Ob + (tt * 16 + fq * 4) * PP + col;
            o[0] = (bf16_t)(w0 & 0xffffu); o[PP] = (bf16_t)(w0 >> 16); o[2 * PP] = (bf16_t)(w1 & 0xffffu); o[3 * PP] = (bf16_t)(w1 >> 16);
        }
    }
    __syncthreads();
    bf16_t* mix = (bf16_t*)(p.ws + WS_MIX);
    for (int i = tid; i < NT * 64; i += 512) { const int r = i >> 6, c8 = (i & 63) * 8;
        st16_wt(mix + (size_t)(rowbase + r) * D + 512 + c8, *(const LAS u32x4*)(Ob + r * PP + c8)); }
}
constexpr int PNT = 64;
template <int WIN>
__device__ __forceinline__ void pool_body(const bf16_t* base, LAS bf16_t* Pd, int tb) {
    float xv[WIN + PNT - 1];
#pragma unroll
    for (int i = 0; i < WIN + PNT - 1; ++i) { const int t = tb - (WIN - 1) + i; xv[i] = (t >= 0) ? bf1(base[(size_t)t * POD_LD]) : 0.f; }
    float s = 0.f;
#pragma unroll
    for (int i = 0; i < WIN - 1; ++i) s += xv[i];
#pragma unroll
    for (int tt = 0; tt < PNT; ++tt) { const float x = xv[WIN - 1 + tt]; s += x; const int t = tb + tt;
        const float inv = (t + 1 < WIN) ? 1.f / (float)(t + 1) : 1.f / (float)WIN;
        const float pv = s * inv - x;
        Pd[tt * PP] = (bf16_t)(cvt_pk_bf16(pv, 0.f) & 0xffffu);
        s -= xv[tt]; }
}
__device__ __forceinline__ void pool_item(const Params& p, LAS unsigned char* L, int item) {
    const int c = threadIdx.x, b = item >> 5, tb = (item & 31) * PNT, g = c >> 7;
    const bf16_t* base = (const bf16_t*)(p.ws + WS_H) + (size_t)(b * SEQ) * POD_LD + 512 + c;
    LAS bf16_t* Pd = (LAS bf16_t*)L; LAS bf16_t* Ob = Pd + PNT * PP;
    PoolB B; pool_loadb(p, B);
    if (g == 0) pool_body<2>(base, Pd + c, tb); else if (g == 1) pool_body<4>(base, Pd + c, tb); else if (g == 2) pool_body<8>(base, Pd + c, tb); else pool_body<16>(base, Pd + c, tb);
#if defined(PROBEP) && PROBEP == 1
    asm volatile("" ::: "memory");
    if (g == 0) pool_body<2>(base, Pd + c, tb); else if (g == 1) pool_body<4>(base, Pd + c, tb); else if (g == 2) pool_body<8>(base, Pd + c, tb); else pool_body<16>(base, Pd + c, tb);
#endif
    __syncthreads();
    pool_mma<PNT>(p, B, Pd, Ob, b * SEQ + tb);
    __syncthreads();
#if defined(PROBEP) && PROBEP == 2
    pool_mma<PNT>(p, B, Pd, Ob, b * SEQ + tb);
    __syncthreads();
#endif
}
__device__ __forceinline__ void pool_s_item(const Params& p, LAS unsigned char* L, int item) {
    const int c = threadIdx.x, win = 2 << (c >> 7);
    LAS bf16_t* Pd = (LAS bf16_t*)L; LAS bf16_t* Ob = Pd + 32 * PP;
    PoolB B; pool_loadb(p, B);
#pragma unroll 1
    for (int q0 = 0; q0 < 16; q0 += 4) {
        float sv[4][15], xq[4];
#pragma unroll
        for (int qq = 0; qq < 4; ++qq) { const int seq = item * 16 + q0 + qq; const float* st = p.in[4] + (size_t)seq * 15 * 512 + c;
            xq[qq] = bf1(((const bf16_t*)(p.ws + WS_H))[(size_t)(MP + seq) * POD_LD + 512 + c]);
#pragma unroll
            for (int j = 0; j < 15; ++j) sv[qq][j] = st[j * 512]; }
#pragma unroll
        for (int qq = 0; qq < 4; ++qq) { const int seq = item * 16 + q0 + qq; float* so = p.out + O_POOLS + (size_t)seq * 15 * 512 + c;
            float tot = xq[qq];
#pragma unroll
            for (int j = 0; j < 15; ++j) { if (j >= 1) so[(j - 1) * 512] = sv[qq][j]; if (15 - j <= win - 1) tot += sv[qq][j]; }
            const float pv = tot / (float)win - xq[qq];
            Pd[(q0 + qq) * PP + c] = (bf16_t)(cvt_pk_bf16(pv, 0.f) & 0xffffu); }
    }
    __syncthreads();
    pool_mma<16>(p, B, Pd, Ob, MP + item * 16);
    __syncthreads();
}

__device__ __forceinline__ void skinny_resid_item(const Params& p, LAS unsigned char* L, const bf16_t* A, const bf16_t* Bt, int K, float scale, const float* xin_s  , int item) {
    const int tid = threadIdx.x, wave = tid >> 6, lane = tid & 63, fr = lane & 15, fq = lane >> 4;
    const int rg = item & 7, cgp = item >> 3;
    const int kw = K >> 3, ksteps = kw >> 5;
    const bf16_t* ap = A + (size_t)(rg * 16 + fr) * K + wave * kw + fq * 8;
    const bf16_t* bp = Bt + (size_t)(cgp * 64 + fr) * K + wave * kw + fq * 8;
    f32x4 acc[4];
#pragma unroll
    for (int n = 0; n < 4; ++n) acc[n] = (f32x4){0.f, 0.f, 0.f, 0.f};
#pragma unroll 6
    for (int ks = 0; ks < ksteps; ++ks) {
        const bf16x8 a = *(const bf16x8*)(ap + ks * 32);
#pragma unroll
        for (int n = 0; n < 4; ++n) { const bf16x8 b = *(const bf16x8*)(bp + (size_t)n * 16 * K + ks * 32); acc[n] = __builtin_amdgcn_mfma_f32_16x16x32_bf16(a, b, acc[n], 0, 0, 0); }
    }
    LAS float* red = (LAS float*)L;
#pragma unroll
    for (int n = 0; n < 4; ++n)
#pragma unroll
        for (int j = 0; j < 4; ++j) red[wave * 1024 + (fq * 4 + j) * 64 + n * 16 + fr] = acc[n][j];
    __syncthreads();
    const int o = tid * 2, r = o >> 6, c = o & 63;
    float s0 = 0.f, s1 = 0.f;
#pragma unroll
    for (int w = 0; w < 8; ++w) { const f32x2 v = *(const LAS f32x2*)(red + w * 1024 + o); s0 += v.x; s1 += v.y; }
    const int lrow = rg * 16 + r, row = MP + lrow, col = cgp * 64 + c;
    unsigned* xbp = (unsigned*)((bf16_t*)(p.ws + WS_XB) + (size_t)row * D + col);
    f32x2 xi;
    if (xin_s) xi = *(const f32x2*)(xin_s + (size_t)lrow * D + col); else { const unsigned w = *xbp; xi = (f32x2){bf_lo(w), bf_hi(w)}; }
    const float x0 = xi.x + scale * s0, x1 = xi.y + scale * s1;
    *xbp = cvt_pk_bf16(x0, x1);
    float sq = x0 * x0 + x1 * x1;
#pragma unroll
    for (int of = 1; of < 32; of <<= 1) sq += __shfl_xor(sq, of);
    if ((tid & 31) == 0) ((float*)(p.ws + WS_SSQ))[(size_t)row * 16 + cgp] = sq;
    __syncthreads();
}

#define XB_TMO      128
#define XB_XCNT(j)  (256  + 64 * (j))
#define XB_XSUB(j)  (1280 + 64 * (j))
#define XB_XGEN(j)  (2304 + 64 * (j))
#define XB_TOP      3328
#define XB_TOPGEN   3392
#define XCD_BAR_WORDS 3456
#define XB_SPIN_CAP (1u << 20)
__device__ __forceinline__ unsigned xb_ld(unsigned* p)              { return __hip_atomic_load(p, __ATOMIC_RELAXED, __HIP_MEMORY_SCOPE_AGENT); }
__device__ __forceinline__ unsigned xb_add(unsigned* p, unsigned v) { return __hip_atomic_fetch_add(p, v, __ATOMIC_RELAXED, __HIP_MEMORY_SCOPE_AGENT); }
__device__ __forceinline__ unsigned xb_xcc_id() { return (unsigned)__builtin_amdgcn_s_getreg((3 << 11) | 20) & 0xFu; }
#define XB_SPIN(cond, bar) do { unsigned _sp = 0; while (cond) { __builtin_amdgcn_s_sleep(1); \
    if ((++_sp & 255u) == 0u) { if (xb_ld(&(bar)[XB_TMO])) break; if (_sp > XB_SPIN_CAP) { atomicAdd(&(bar)[XB_TMO], 1u); break; } } } } while (0)
struct XcdBarrier { unsigned* bar; unsigned x; volatile LAS unsigned* st; };
__device__ __forceinline__ XcdBarrier xcd_barrier_post(unsigned* bar, volatile LAS unsigned* st) {
    XcdBarrier b; b.bar = bar; b.x = xb_xcc_id(); b.st = st;
    if (threadIdx.x == 0) (void)xb_add(&bar[XB_XCNT(b.x)], 1u);
    return b;
}
__device__ __forceinline__ void xcd_barrier_complete(unsigned* bar, unsigned x, unsigned& nloc, unsigned& nx) {
    const unsigned G = gridDim.x * gridDim.y * gridDim.z;
    unsigned sum, cnt, mine, sp = 0u;
    for (;;) {
        sum = 0u; cnt = 0u; mine = 0u;
#pragma unroll
        for (unsigned j = 0; j < 16; ++j) { const unsigned c = xb_ld(&bar[XB_XCNT(j)]); sum += c; cnt += (c > 0u) ? 1u : 0u; mine = (j == x) ? c : mine; }
        if (sum == G) break;
        __builtin_amdgcn_s_sleep(1);
        if ((++sp & 255u) == 0u) { if (xb_ld(&bar[XB_TMO])) break; if (sp > XB_SPIN_CAP) { atomicAdd(&bar[XB_TMO], 1u); break; } }
    }
    nloc = mine > 0u ? mine : 1u; nx = cnt > 0u ? cnt : 1u;
}
__device__ __forceinline__ void xcd_barrier(const XcdBarrier& b) {
    asm volatile("s_waitcnt vmcnt(0)" ::: "memory");
    __syncthreads();
    if (threadIdx.x == 0) {
        unsigned* bar = b.bar;
        __builtin_amdgcn_s_waitcnt(0);
        unsigned nloc = b.st[0], nx = b.st[1];
        if (nloc == 0u) { xcd_barrier_complete(bar, b.x, nloc, nx); b.st[0] = nloc; b.st[1] = nx; }
        const unsigned old = xb_add(&bar[XB_XSUB(b.x)], 1u);
        const unsigned gen = old / nloc;
        if (old + 1u == (gen + 1u) * nloc) {
            __builtin_amdgcn_fence(__ATOMIC_RELEASE, "agent");
            asm volatile("s_waitcnt vmcnt(0)" ::: "memory");
            const unsigned og = xb_add(&bar[XB_TOP], 1u);
            const unsigned tg = og / nx;
            if (og + 1u == (tg + 1u) * nx) xb_add(&bar[XB_TOPGEN], 1u);
            else XB_SPIN(xb_ld(&bar[XB_TOPGEN]) == tg, bar);
            __builtin_amdgcn_fence(__ATOMIC_ACQUIRE, "agent");
            xb_add(&bar[XB_XGEN(b.x)], 1u);
            asm volatile("s_waitcnt vmcnt(0)" ::: "memory");
        } else {
            XB_SPIN(xb_ld(&bar[XB_XGEN(b.x)]) == gen, bar);
            __builtin_amdgcn_fence(__ATOMIC_ACQUIRE, "agent");
            asm volatile("s_waitcnt vmcnt(0)" ::: "memory");
        }
    }
    __syncthreads();
}

__device__ __forceinline__ void ffn_in_phase(const Params& p, LAS unsigned char* L, int idx, int lo1, int hi1, int lo2, int hi2) {
    pg8::Gemm g{(const bf16_t*)(p.ws + WS_XB), (const bf16_t*)(p.ws + WS_WFFIN) + (size_t)idx * 5632 * 1024, MPAD, 5632, 1024};
    pg8::StaticOrder S; S.init(MPAD, 5632, gridDim.x, blockIdx.x);
    EpiFfnIn E{(bf16_t*)(p.ws + WS_H), (const float*)(p.ws + WS_SSQ)};
    pg8::gemm_phase<EpiFfnIn>(L, g, S, E);
    tail_prep(p, L, (MPAD / 256) * 22, lo1, hi1, lo2, hi2);
}
template <bool FIRST>
__device__ __forceinline__ void resid_phase(const Params& p, LAS unsigned char* L, const bf16_t* A, const bf16_t* Bt, int K, float scale) {
    pg8::Gemm g{A, Bt, MP, 1024, K};
    pg8::StaticOrder S; S.init(MP, 1024, gridDim.x, blockIdx.x);
    if (p.dry) scale = 0.f;
    EpiResid<FIRST> E{p.in[0], (bf16_t*)(p.ws + WS_XB), (float*)(p.ws + WS_SSQ), scale};
    pg8::gemm_phase<EpiResid<FIRST>>(L, g, S, E);
    for (int it = (int)gridDim.x - 1 - (int)blockIdx.x; it < 128; it += gridDim.x) skinny_resid_item(p, L, A + (size_t)MP * K, Bt, K, scale, FIRST ? p.in[1] : nullptr, it);
}

__global__ void __launch_bounds__(512, 2) mk_fwd(Params p) {
    extern __shared__ __attribute__((aligned(16))) unsigned char lds_raw[];
    LAS unsigned char* L = (LAS unsigned char*)lds_raw;
    const int tid = threadIdx.x, G = gridDim.x, bx = blockIdx.x;
    const int lo = p.ph_lo, hi = p.ph_hi;
    int ph = 0;
#if MK_MULTI
#define SEAM() do { ++ph; } while (0)
#else
    if (tid < 4) ((LAS unsigned*)(L + LDS_BYTES - 16))[tid] = 0u;
    __syncthreads();
    const XcdBarrier xbar = xcd_barrier_post((unsigned*)(p.ws + WS_BAR), (volatile LAS unsigned*)(L + LDS_BYTES - 16));
    if (p.ph_hi < 0) cg::this_grid().sync();
#define SEAM() do { ++ph; xcd_barrier(xbar); } while (0)
#endif
#define IN() (lo <= ph && ph < hi)
    const bf16_t* XB = (const bf16_t*)(p.ws + WS_XB);
    const bf16_t* Hb = (const bf16_t*)(p.ws + WS_H);
    const bf16_t* MIX = (const bf16_t*)(p.ws + WS_MIX);
    const bf16_t* WFFOUT = (const bf16_t*)(p.ws + WS_WFFOUT);

    if (IN()) phase_prep(p, L);
    SEAM();
    if (IN()) ffn_in_phase(p, L, 0, 5632, 6336, 8448, 9408);
    SEAM();
    if (IN()) resid_phase<true>(p, L, Hb, WFFOUT, DFF, 0.5f);
    SEAM();
    if (IN()) {
        pg8::Gemm g{XB, (const bf16_t*)(p.ws + WS_WEVIN), MPAD, EVN, 1024};
        pg8::StaticOrder S; S.init(MPAD, EVN, G, bx);
        EpiEvIn E{(bf16_t*)(p.ws + WS_H), (float*)(p.ws + WS_Z), (const float*)(p.ws + WS_SSQ)};
        pg8::gemm_phase<EpiEvIn>(L, g, S, E);
        tail_prep(p, L, (MPAD / 256) * 11, 1408, 2816, 0, 0);
    }
    SEAM();
    if (IN()) {
        for (int sl = bx; sl < 1024; sl += G) gla_a_item(p, L, (G & 7) ? sl : (sl & 7) * 128 + (sl >> 3));
        for (int sl = bx; sl < 512; sl += G) sg_item(p, L, (G & 7) ? sl : (sl & 7) * 64 + (sl >> 3));
        for (int s = bx * 8 + (tid >> 6); s < NS; s += G * 8) sg_s_row(p, s, tid & 63);
    }
    SEAM();
    if (IN()) { for (int sl = bx; sl < 512; sl += G) gla_scan_item(p, (G & 7) ? sl : (sl & 7) * 64 + (sl >> 3)); }
    SEAM();
    if (IN()) {
        for (int sl = bx; sl < 1024; sl += G) gla_c_item(p, L, (G & 7) ? sl : (sl & 7) * 128 + (sl >> 3));
        for (int it = bx; it < 512; it += G) gla_s_item(p, L, it);
    }
    SEAM();
    if (IN()) resid_phase<false>(p, L, MIX, (const bf16_t*)(p.ws + WS_WEVOUT), 1024, 1.0f);
    SEAM();
    if (IN()) ffn_in_phase(p, L, 1, 6336, 7040, 2816, 4224);
    SEAM();
    if (IN()) resid_phase<false>(p, L, Hb, WFFOUT + (size_t)1 * 1024 * 2816, DFF, 0.5f);
    SEAM();
    if (IN()) ffn_in_phase(p, L, 2, 7040, 7744, 9408, 10112);
    SEAM();
    if (IN()) resid_phase<false>(p, L, Hb, WFFOUT + (size_t)2 * 1024 * 2816, DFF, 0.5f);
    SEAM();
    if (IN()) {
        pg8::Gemm g{XB, (const bf16_t*)(p.ws + WS_WODIN), MPAD, ODN, 1024};
        pg8::StaticOrder S; S.init(MPAD, ODN, G, bx);
        EpiOdIn E{(bf16_t*)(p.ws + WS_H), p.out, (const float*)(p.ws + WS_SSQ)};
        pg8::gemm_phase<EpiOdIn>(L, g, S, E);
        tail_prep(p, L, (MPAD / 256) * 6, 4224, 5632, 0, 0);
    }
    SEAM();
    if (IN()) {
        for (int sl = bx; sl < 512; sl += G) conv_item(p, L, (G & 7) ? sl : (sl & 7) * 64 + (sl >> 3));
#if defined(PROBE13) && PROBE13 == 1
        for (int it = bx; it < 512; it += G) conv_item(p, L, it);
#endif
        for (int it = bx; it < NS; it += G) conv_s_item(p, L, it);
#if defined(PROBE13) && PROBE13 == 3
        for (int it = bx; it < NS; it += G) conv_s_item(p, L, it);
#endif
        for (int sl = bx; sl < 256; sl += G) pool_item(p, L, (G & 7) ? sl : (sl & 7) * 32 + (sl >> 3));
        for (int it = G - 1 - bx; it < 8; it += G) pool_s_item(p, L, it);
    }
    SEAM();
    if (IN()) resid_phase<false>(p, L, MIX, (const bf16_t*)(p.ws + WS_WODOUT), 1024, 1.0f);
    SEAM();
    if (IN()) ffn_in_phase(p, L, 3, 7744, 8448, 0, 0);
    SEAM();
    if (IN()) resid_phase<false>(p, L, Hb, WFFOUT + (size_t)3 * 1024 * 2816, DFF, 0.5f);
    SEAM();
    if (IN()) {
        const int lane = tid & 63; const float* ssq = (const float*)(p.ws + WS_SSQ);
        const f32x4 g0[2] = {*(const f32x4*)(p.in[25] + 8 * lane), *(const f32x4*)(p.in[25] + 8 * lane + 512)};
        const f32x4 g1[2] = {*(const f32x4*)(p.in[25] + 8 * lane + 4), *(const f32x4*)(p.in[25] + 8 * lane + 516)};
        for (int row = bx * 8 + (tid >> 6); row < MT; row += 2 * G * 8) {
            const int row2 = row + G * 8; const bool has2 = row2 < MT; const int r2 = has2 ? row2 : row;
            u32x4 w[2][2]; f32x4 sq[2];
#pragma unroll
            for (int j = 0; j < 2; ++j) { w[0][j] = *(const u32x4*)(XB + (size_t)row * D + 8 * lane + 512 * j); w[1][j] = *(const u32x4*)(XB + (size_t)r2 * D + 8 * lane + 512 * j); }
            sq[0] = *(const f32x4*)(ssq + (size_t)row * 16 + 4 * (lane & 3)); sq[1] = *(const f32x4*)(ssq + (size_t)r2 * 16 + 4 * (lane & 3));
#pragma unroll
            for (int q = 0; q < 2; ++q) {
                float t = (sq[q].x + sq[q].y) + (sq[q].z + sq[q].w); t += __shfl_xor(t, 1); t += __shfl_xor(t, 2);
                const float rs = rsqrtf(t * (1.f / 1024.f) + EPS);
                if (q == 0 || has2) {
                    float* o = p.out + O_Y + (size_t)(q ? r2 : row) * D + 8 * lane;
#pragma unroll
                    for (int j = 0; j < 2; ++j) { const u32x4 x = w[q][j];
                        *(f32x4*)(o + 512 * j) = (f32x4){bf_lo(x.x), bf_hi(x.x), bf_lo(x.y), bf_hi(x.y)} * rs * g0[j];
                        *(f32x4*)(o + 512 * j + 4) = (f32x4){bf_lo(x.z), bf_hi(x.z), bf_lo(x.w), bf_hi(x.w)} * rs * g1[j]; }
                }
            }
        }
    }
#undef IN
#undef SEAM
}
constexpr int N_PHASES = 18;

extern "C" void kernel_launch(void* const* d_in, const int* in_sizes, int n_in, void* d_out, int out_size, void* d_ws, size_t ws_size, hipStream_t stream) {
    static int grid = 0;
    if (grid == 0) {
        if (n_in != 26 || ws_size < WS_END) { fprintf(stderr, "kernel_launch: unexpected n_in %d / ws_size %zu (need %zu)\n", n_in, ws_size, (size_t)WS_END); grid = -1; return; }
        int dev = 0, cus = 0, per_cu = 0;
        hipGetDevice(&dev);
        hipDeviceGetAttribute(&cus, hipDeviceAttributeMultiprocessorCount, dev);
        if (hipFuncSetAttribute((const void*)mk_fwd, hipFuncAttributeMaxDynamicSharedMemorySize, LDS_BYTES) != hipSuccess) { fprintf(stderr, "kernel_launch: hipFuncSetAttribute failed\n"); grid = -1; return; }
        if (hipOccupancyMaxActiveBlocksPerMultiprocessor(&per_cu, (const void*)mk_fwd, 512, LDS_BYTES) != hipSuccess || per_cu < 1) { fprintf(stderr, "kernel_launch: occupancy query gave %d\n", per_cu); per_cu = 1; }
        (void)hipGetLastError();
        grid = cus * per_cu;
        fprintf(stderr, "kernel_launch: grid %d (cus %d x %d)\n", grid, cus, per_cu);
    }
    if (grid < 0) return;
    Params p{};
    for (int i = 0; i < 26; ++i) p.in[i] = (const float*)d_in[i];
    p.out = (float*)d_out; p.ws = (unsigned char*)d_ws;
#if MK_MULTI
    for (int ph = 0; ph < N_PHASES; ++ph) {
        int reps = 1;
#ifdef PROBE_EXTRA
        { const int ex[] = PROBE_EXTRA; for (unsigned i = 0; i < sizeof(ex) / sizeof(int); ++i) if (ex[i] == ph) ++reps; }
#endif
        for (int r = 0; r < reps; ++r) { p.ph_lo = ph; p.ph_hi = ph + 1; p.dry = r; hipLaunchKernelGGL(mk_fwd, dim3(grid), dim3(512), LDS_BYTES, stream, p); }
    }
#else
    p.ph_lo = 0; p.ph_hi = N_PHASES;
    if (hipMemsetAsync((char*)d_ws + WS_BAR, 0, XCD_BAR_WORDS * 4, stream) != hipSuccess) { fprintf(stderr, "kernel_launch: memset failed\n"); return; }
    void* args[] = {&p};
    hipError_t e = hipLaunchCooperativeKernel((const void*)mk_fwd, dim3(grid), dim3(512), args, LDS_BYTES, stream);
    if (e != hipSuccess) fprintf(stderr, "kernel_launch: cooperative launch failed: %s (grid %d)\n", hipGetErrorString(e), grid);
#endif
}
```

```cpp
#include <hip/hip_runtime.h>
#include <hip/hip_cooperative_groups.h>
#include <cstdio>
#include <cstdint>
namespace cg = cooperative_groups;

#define LAS __attribute__((address_space(3)))
typedef unsigned short bf16_t;
typedef short bf16x8 __attribute__((ext_vector_type(8)));
typedef float f32x4 __attribute__((ext_vector_type(4)));
typedef float f32x2 __attribute__((ext_vector_type(2)));
typedef unsigned u32x4 __attribute__((ext_vector_type(4)));
typedef unsigned u32x2 __attribute__((ext_vector_type(2)));

#ifndef MK_MULTI
#define MK_MULTI 0
#endif

constexpr int D = 1024, SEQ = 2048, MP = 16384, NS = 128, MT = 16512, MPAD = 16640, DFF = 2816;
constexpr int EVN = 2816, ODN = 1536, PEV_LD = 2816, POD_LD = 1024;
constexpr float EPS = 1e-6f;
constexpr size_t O_Y = 0, O_GLAP = 16908288, O_GLAS = 17170432, O_SGVP = 21364736, O_SGVS = 21889024,
                 O_CONVP = 21954560, O_CONVS = 22077440, O_POOLP = 24043520, O_POOLS = 24104960;
constexpr size_t WS_WFFIN = 0;
constexpr size_t WS_WFFOUT = WS_WFFIN + 4ull * 11534336;
constexpr size_t WS_WEVIN = WS_WFFOUT + 4ull * 5767168;
constexpr size_t WS_WEVOUT = WS_WEVIN + 5767168;
constexpr size_t WS_WODIN = WS_WEVOUT + 2097152;
constexpr size_t WS_WODOUT = WS_WODIN + 3145728;
constexpr size_t WS_WPOOL = WS_WODOUT + 2097152;
constexpr size_t WS_X = WS_WPOOL + 524288;
constexpr size_t WS_XB = WS_X + 68157440;
constexpr size_t WS_SSQ = WS_XB + 34078720;
constexpr size_t WS_H = WS_SSQ + 1064960;
constexpr size_t WS_Z = WS_H + 93716480;
constexpr size_t WS_MIX = WS_Z + 1064960;
constexpr size_t WS_KV = WS_MIX + 34078720;
constexpr size_t WS_DEC = WS_KV + 33554432;
constexpr size_t WS_BAR = WS_DEC + 262144;
constexpr size_t WS_END = WS_BAR + 16384;
constexpr int LDS_BYTES = 147456;

struct Params {
    const float* in[26];
    float* out;
    unsigned char* ws;
    int ph_lo, ph_hi, dry, pad;
};

typedef __bf16 bf16x2_t __attribute__((ext_vector_type(2)));
__device__ __forceinline__ unsigned cvt_pk_bf16(float lo, float hi) { const f32x2 v = {lo, hi}; const bf16x2_t b = __builtin_convertvector(v, bf16x2_t); return __builtin_bit_cast(unsigned, b); }
__device__ __forceinline__ float bf_lo(unsigned w) { return __uint_as_float(w << 16); }
__device__ __forceinline__ float bf_hi(unsigned w) { return __uint_as_float(w & 0xffff0000u); }
__device__ __forceinline__ float bf1(bf16_t b) { return __uint_as_float(((unsigned)b) << 16); }
__device__ __forceinline__ float wave_sum(float v) {
#pragma unroll
    for (int o = 1; o < 64; o <<= 1) v += __shfl_xor(v, o);
    return v;
}
__device__ __forceinline__ float fsigmoid(float x) { return __builtin_amdgcn_rcpf(1.f + __builtin_amdgcn_exp2f(-1.4426950408889634f * x)); }
__device__ __forceinline__ float fsilu(float x) { return x * fsigmoid(x); }
__device__ __forceinline__ float fgelu(float x) { return x * fsigmoid(1.5957691216057308f * (x + 0.044715f * x * x * x)); }
#define LDS_WAIT() asm volatile("s_waitcnt lgkmcnt(0)" ::: "memory")
__device__ __forceinline__ void st16_wt(void* ptr, u32x4 v) { asm volatile("global_store_dwordx4 %0, %1, off sc1\n\ts_nop 2" :: "v"(ptr), "v"(v) : "memory"); }

namespace pg8 {
constexpr int BM = 256, BK = 64, HALF = 128, HTB = HALF * BK * 2, STAGE_BYTES = 8 * HTB, NXCD = 8, WGM = 8;
__host__ __device__ __forceinline__ int lds_byte(int r, int c) { const int st = (r >> 4) * 2 + (c >> 5), rr = r & 15, cc = c & 31, ob = rr * 64 + cc * 2; return st * 1024 + (ob ^ (((ob >> 9) & 1) << 5)); }
__host__ __device__ __forceinline__ void stage_rc(int b, int& R, int& C) { const int st = b / 1024, sb = b % 1024, swz = sb ^ (((sb >> 9) & 1) << 5); R = (st >> 1) * 16 + swz / 64; C = (st & 1) * 32 + (swz % 64) / 2; }
__host__ __device__ __forceinline__ int perm32(int rho) { const int n = rho >> 4, i = rho & 15; return 8 * (i >> 2) + 4 * n + (i & 3); }
struct Unit { int pm, pn; };
struct Gemm { const bf16_t* A; const bf16_t* Bt; int M, N, K; };
struct StaticOrder {
    int nM, nN, nwg, G, c;
    __host__ __device__ void init(int M, int N, int G_, int c_) { nM = M / BM; nN = N / BM; nwg = nM * nN; G = G_; c = c_; }
    __host__ __device__ bool next(int i, Unit& u) const {
        const long L = (long)i * G + c; if (L >= nwg) return false;
        int wgid = (int)L; { const int q = nwg / NXCD, r = nwg % NXCD, xcd = wgid % NXCD, off = wgid / NXCD; wgid = (xcd < r ? xcd * (q + 1) : r * (q + 1) + (xcd - r) * q) + off; }
        const int nig = WGM * nN, gid = wgid / nig, fm = gid * WGM, gsz = (nM - fm) < WGM ? (nM - fm) : WGM;
        u.pm = fm + ((wgid % nig) % gsz); u.pn = (wgid % nig) / gsz; return true;
    }
};
template <class Epi, bool ALIGN_EPI = true>
__device__ __forceinline__ void gemm_phase(LAS unsigned char* lds, const Gemm g, const StaticOrder& S, const Epi& E) {
    const int tid = threadIdx.x, wid = __builtin_amdgcn_readfirstlane(tid >> 6), lane = tid & 63, wr = wid >> 2, wc = wid & 3, fr = lane & 15, fq = lane >> 4;
    const int K = g.K, nt = K / BK;
    unsigned voffA[2], voffB[2];
#pragma unroll
    for (int i = 0; i < 2; ++i) { int R, C; stage_rc(tid * 16 + i * 8192, R, C); const int Rb = Epi::PERM ? ((R & ~31) + perm32(R & 31)) : R;
        voffA[i] = (unsigned)(R * K + C) * 2u; voffB[i] = (unsigned)(Rb * K + C) * 2u; }
    const size_t kstep = (size_t)(BK * 2);
    const size_t hstep = (size_t)HALF * K * 2;
    const size_t tstep = 2 * hstep;
    const unsigned ldsw = (unsigned)wid * 1024u;
    const int aoff = lds_byte(wr * 64 + fr, fq * 8), boff = lds_byte(wc * 32 + fr, fq * 8);
#define PG8_SA(b, h) (((b) * 2 + (h)) * HTB)
#define PG8_SB(b, h) ((4 + (b) * 2 + (h)) * HTB)
#define PG8_STAGE(bufoff, gbase, voff) do { _Pragma("unroll") for (int _i = 0; _i < 2; ++_i) \
        __builtin_amdgcn_global_load_lds((const unsigned*)((const char*)(gbase) + (voff)[_i]), (LAS unsigned*)(lds + (bufoff) + ldsw + _i * 8192), 16, 0, 0); } while (0)
#define PG8_LDA(dst, b, h) do { _Pragma("unroll") for (int m = 0; m < 4; ++m) _Pragma("unroll") for (int k = 0; k < 2; ++k) dst[m][k] = *(const LAS bf16x8*)(lds + PG8_SA(b, h) + aoff + m * 2048 + k * 1024); } while (0)
#define PG8_LDB(dst, b, h) do { _Pragma("unroll") for (int n = 0; n < 2; ++n) _Pragma("unroll") for (int k = 0; k < 2; ++k) dst[n][k] = *(const LAS bf16x8*)(lds + PG8_SB(b, h) + boff + n * 2048 + k * 1024); } while (0)
#define PG8_MMA(ai, bj, At, Bt) do { __builtin_amdgcn_s_setprio(1); _Pragma("unroll") for (int m = 0; m < 4; ++m) _Pragma("unroll") for (int n = 0; n < 2; ++n) _Pragma("unroll") for (int k = 0; k < 2; ++k) \
        acc[ai][bj][m][n] = __builtin_amdgcn_mfma_f32_16x16x32_bf16(Bt[n][k], At[m][k], acc[ai][bj][m][n], 0, 0, 0); __builtin_amdgcn_s_setprio(0); } while (0)
#define PG8_WAIT_V(n) asm volatile("s_waitcnt vmcnt(" #n ")" ::: "memory")
#define PG8_WAIT_L(n) asm volatile("s_waitcnt lgkmcnt(" #n ")" ::: "memory")
#define PG8_BAR __builtin_amdgcn_s_barrier()
#define PG8_SCHED __builtin_amdgcn_sched_barrier(0)
    Unit cur, nxt; int ui = 0;
    if (!S.next(0, cur)) return;
    LAS float* rl = (LAS float*)(lds + STAGE_BYTES);
    { typename Epi::Raw raw0; E.pre_issue(cur, wr, fr, fq, raw0); E.pre_finish(raw0, rl, wr, wc, fr, fq); }
    f32x4 acc[2][2][4][2];
#pragma unroll
    for (int a = 0; a < 2; ++a)
#pragma unroll
        for (int b = 0; b < 2; ++b)
#pragma unroll
            for (int m = 0; m < 4; ++m)
#pragma unroll
                for (int n = 0; n < 2; ++n) acc[a][b][m][n] = (f32x4){0.f, 0.f, 0.f, 0.f};
    bf16x8 At[4][2], B0[2][2], B1[2][2];
    const char* cA = (const char*)g.A + (size_t)cur.pm * tstep; const char* cB = (const char*)g.Bt + (size_t)cur.pn * tstep;
    PG8_STAGE(PG8_SB(0, 0), cB, voffB); PG8_STAGE(PG8_SB(0, 1), cB + hstep, voffB); PG8_STAGE(PG8_SA(0, 0), cA, voffA); PG8_STAGE(PG8_SA(0, 1), cA + hstep, voffA);
    if (wr == 1) PG8_BAR;
    PG8_WAIT_V(2); PG8_BAR;
    PG8_STAGE(PG8_SB(1, 0), cB + kstep, voffB); PG8_STAGE(PG8_SA(1, 0), cA + kstep, voffA); PG8_STAGE(PG8_SB(1, 1), cB + hstep + kstep, voffB);
    PG8_WAIT_V(6); PG8_BAR;
    for (;;) {
        const bool has_next = S.next(ui + 1, nxt);
        const char* nA = has_next ? (const char*)g.A + (size_t)nxt.pm * tstep : cA; const char* nB = has_next ? (const char*)g.Bt + (size_t)nxt.pn * tstep : cB;
        for (int t = 0; t < nt; t += 2) {
            const bool last = (t == nt - 2);
            const char* a1 = cA + (size_t)(t + 1) * kstep;
            const char* a2 = last ? nA : cA + (size_t)(t + 2) * kstep; const char* b2 = last ? nB : cB + (size_t)(t + 2) * kstep;
            const char* a3 = a2 + kstep; const char* b3 = b2 + kstep;
            PG8_LDB(B0, 0, 0); PG8_LDB(B1, 0, 1); PG8_SCHED; PG8_LDA(At, 0, 0); PG8_STAGE(PG8_SA(1, 1), a1 + hstep, voffA);
            PG8_WAIT_V(8); PG8_WAIT_L(0); PG8_BAR; PG8_MMA(0, 0, At, B0); PG8_MMA(0, 1, At, B1); PG8_BAR; PG8_SCHED;
            PG8_LDA(At, 0, 1); PG8_STAGE(PG8_SB(0, 0), b2, voffB); PG8_STAGE(PG8_SB(0, 1), b2 + hstep, voffB); PG8_STAGE(PG8_SA(0, 0), a2, voffA);
            PG8_WAIT_V(8); PG8_WAIT_L(0); PG8_BAR; PG8_MMA(1, 0, At, B0); PG8_MMA(1, 1, At, B1); PG8_BAR; PG8_SCHED;
            PG8_LDB(B0, 1, 0); PG8_LDB(B1, 1, 1); PG8_SCHED; PG8_LDA(At, 1, 0); PG8_STAGE(PG8_SA(0, 1), a2 + hstep, voffA);
            PG8_WAIT_V(8); PG8_WAIT_L(0); PG8_BAR; PG8_MMA(0, 0, At, B0); PG8_MMA(0, 1, At, B1); PG8_BAR; PG8_SCHED;
            PG8_LDA(At, 1, 1); PG8_STAGE(PG8_SB(1, 0), b3, voffB); PG8_STAGE(PG8_SB(1, 1), b3 + hstep, voffB); PG8_STAGE(PG8_SA(1, 0), a3, voffA);
            PG8_WAIT_V(8); PG8_WAIT_L(0); PG8_BAR; PG8_MMA(1, 0, At, B0); PG8_MMA(1, 1, At, B1); PG8_BAR; PG8_SCHED;
        }
        if constexpr (ALIGN_EPI) { if (wr == 0) PG8_BAR; }
        typename Epi::Raw raw; if (has_next) E.pre_issue(nxt, wr, fr, fq, raw);
        E(acc, cur, wr, wc, fr, fq, rl + (ui & 1) * 256);
        if (has_next) E.pre_finish(raw, rl + ((ui + 1) & 1) * 256, wr, wc, fr, fq);
        if (!has_next) break;
#pragma unroll
        for (int a = 0; a < 2; ++a)
#pragma unroll
            for (int b = 0; b < 2; ++b)
#pragma unroll
                for (int m = 0; m < 4; ++m)
#pragma unroll
                    for (int n = 0; n < 2; ++n) acc[a][b][m][n] = (f32x4){0.f, 0.f, 0.f, 0.f};
        cur = nxt; cA = nA; cB = nB; ++ui;
        if constexpr (ALIGN_EPI) { if (wr == 1) PG8_BAR; }
    }
    PG8_WAIT_V(0);
    if constexpr (!ALIGN_EPI) { if (wr == 0) PG8_BAR; }
    PG8_BAR;
#undef PG8_SA
#undef PG8_SB
#undef PG8_STAGE
#undef PG8_LDA
#undef PG8_LDB
#undef PG8_MMA
#undef PG8_WAIT_V
#undef PG8_WAIT_L
#undef PG8_BAR
#undef PG8_SCHED
}
}
using pg8::Unit;

struct NoRaw {};
struct RstdRaw { f32x4 a, b; };
__device__ __forceinline__ void rstd_issue(const float* ssq, int pm, RstdRaw& r) {
    const float* sp = ssq + ((size_t)pm * 256 + (threadIdx.x >> 1)) * 16 + (threadIdx.x & 1) * 8;
    r.a = *(const f32x4*)sp; r.b = *(const f32x4*)(sp + 4);
}
__device__ __forceinline__ void rstd_finish(const RstdRaw& r, LAS float* dst) {
    float t = ((r.a.x + r.a.y) + (r.a.z + r.a.w)) + ((r.b.x + r.b.y) + (r.b.z + r.b.w));
    t += __shfl_xor(t, 1);
    if ((threadIdx.x & 1) == 0) dst[threadIdx.x >> 1] = rsqrtf(t * (1.f / 1024.f) + EPS);
}
__device__ __forceinline__ void unit_rstd(const float* ssq, int row0, int fq, float (&rs)[2][4]) {
    f32x4 q[2][4];
#pragma unroll
    for (int ai = 0; ai < 2; ++ai)
#pragma unroll
        for (int m = 0; m < 4; ++m) q[ai][m] = *(const f32x4*)(ssq + (size_t)(row0 + ai * 128 + m * 16) * 16 + 4 * fq);
#pragma unroll
    for (int ai = 0; ai < 2; ++ai)
#pragma unroll
        for (int m = 0; m < 4; ++m) { float t = (q[ai][m].x + q[ai][m].y) + (q[ai][m].z + q[ai][m].w); t += __shfl_xor(t, 16); t += __shfl_xor(t, 32); rs[ai][m] = rsqrtf(t * (1.f / 1024.f) + EPS); }
}
__device__ __forceinline__ float row_rstd(const float* ssq, int row) {
    const f32x4* p = (const f32x4*)(ssq + (size_t)row * 16);
    const f32x4 a = p[0], b = p[1], c = p[2], d = p[3];
    const float s = ((a.x + a.y) + (a.z + a.w)) + ((b.x + b.y) + (b.z + b.w)) + ((c.x + c.y) + (c.z + c.w)) + ((d.x + d.y) + (d.z + d.w));
    return rsqrtf(s * (1.f / 1024.f) + EPS);
}
struct EpiFfnIn {
    static constexpr bool PERM = true;
    bf16_t* H; const float* ssq;
    typedef RstdRaw Raw;
    __device__ __forceinline__ void pre_issue(const Unit& u, int wr, int fr, int fq, Raw& r) const { rstd_issue(ssq, u.pm, r); }
    __device__ __forceinline__ void pre_finish(const Raw& r, LAS float* dst, int wr, int wc, int fr, int fq) const { rstd_finish(r, dst); }
    __device__ __forceinline__ void operator()(const f32x4 (&acc)[2][2][4][2], const Unit& u, int wr, int wc, int fr, int fq, const LAS float* rl) const {
        const int row0 = u.pm * 256 + wr * 64 + fr, col0 = u.pn * 128 + wc * 32 + 8 * fq;
        float rsa[2][4];
#pragma unroll
        for (int ai = 0; ai < 2; ++ai)
#pragma unroll
            for (int m = 0; m < 4; ++m) rsa[ai][m] = rl[ai * 128 + wr * 64 + m * 16 + fr];
#pragma unroll
        for (int ai = 0; ai < 2; ++ai)
#pragma unroll
            for (int m = 0; m < 4; ++m) {
                const int row = row0 + ai * 128 + m * 16; const float rs = rsa[ai][m];
                const float cexp = -1.4426950408889634f * rs, rs2 = rs * rs;
                f32x2 A2[4], B2[4], E2[4], H2[4];
#pragma unroll
                for (int n = 0; n < 2; ++n) { const f32x4 a = acc[ai][0][m][n], b = acc[ai][1][m][n];
                    A2[2 * n] = (f32x2){a.x, a.y}; A2[2 * n + 1] = (f32x2){a.z, a.w}; B2[2 * n] = (f32x2){b.x, b.y}; B2[2 * n + 1] = (f32x2){b.z, b.w}; }
#pragma unroll
                for (int q = 0; q < 4; ++q) { const f32x2 t = A2[q] * cexp; E2[q].x = __builtin_amdgcn_exp2f(t.x); E2[q].y = __builtin_amdgcn_exp2f(t.y); }
#pragma unroll
                for (int q = 0; q < 4; ++q) { const f32x2 d = E2[q] + 1.0f; E2[q].x = __builtin_amdgcn_rcpf(d.x); E2[q].y = __builtin_amdgcn_rcpf(d.y); }
#pragma unroll
                for (int q = 0; q < 4; ++q) H2[q] = (A2[q] * B2[q]) * rs2 * E2[q];
                u32x4 w; w.x = cvt_pk_bf16(H2[0].x, H2[0].y); w.y = cvt_pk_bf16(H2[1].x, H2[1].y); w.z = cvt_pk_bf16(H2[2].x, H2[2].y); w.w = cvt_pk_bf16(H2[3].x, H2[3].y);
                st16_wt(H + (size_t)row * DFF + col0, w);
            }
    }
};
template <bool FIRST>
struct EpiResid {
    static constexpr bool PERM = true;
    const float* xin_p; bf16_t* XB; float* ssq; float scale;
    typedef NoRaw Raw;
    __device__ __forceinline__ void pre_issue(const Unit&, int, int, int, Raw&) const {}
    __device__ __forceinline__ void pre_finish(const Raw&, LAS float*, int, int, int, int) const {}
    __device__ __forceinline__ void operator()(const f32x4 (&acc)[2][2][4][2], const Unit& u, int wr, int wc, int fr, int fq, const LAS float*) const {
        const int row0 = u.pm * 256 + wr * 64 + fr, col0 = u.pn * 256 + wc * 32 + 8 * fq;
#pragma unroll
        for (int ai = 0; ai < 2; ++ai) {
            f32x4 r[4][2][2];
#pragma unroll
            for (int m = 0; m < 4; ++m)
#pragma unroll
                for (int bj = 0; bj < 2; ++bj) {
                    const size_t off = (size_t)(row0 + ai * 128 + m * 16) * D + col0 + bj * 128;
                    if (FIRST) { r[m][bj][0] = *(const f32x4*)(xin_p + off); r[m][bj][1] = *(const f32x4*)(xin_p + off + 4); }
                    else { const u32x4 w = *(const u32x4*)(XB + off);
                        r[m][bj][0] = (f32x4){bf_lo(w.x), bf_hi(w.x), bf_lo(w.y), bf_hi(w.y)}; r[m][bj][1] = (f32x4){bf_lo(w.z), bf_hi(w.z), bf_lo(w.w), bf_hi(w.w)}; }
                }
            asm volatile("" ::: "memory");
#pragma unroll
            for (int m = 0; m < 4; ++m) {
                const int row = row0 + ai * 128 + m * 16;
                float sq = 0.f;
#pragma unroll
                for (int bj = 0; bj < 2; ++bj) {
                    const f32x4 o0 = r[m][bj][0] + acc[ai][bj][m][0] * scale, o1 = r[m][bj][1] + acc[ai][bj][m][1] * scale;
                    sq += ((o0.x * o0.x + o0.y * o0.y) + (o0.z * o0.z + o0.w * o0.w)) + ((o1.x * o1.x + o1.y * o1.y) + (o1.z * o1.z + o1.w * o1.w));
                    u32x4 w; w.x = cvt_pk_bf16(o0.x, o0.y); w.y = cvt_pk_bf16(o0.z, o0.w); w.z = cvt_pk_bf16(o1.x, o1.y); w.w = cvt_pk_bf16(o1.z, o1.w);
                    st16_wt(XB + (size_t)row * D + col0 + bj * 128, w);
                }
                sq += __shfl_xor(sq, 16); sq += __shfl_xor(sq, 32);
                if (fq == 0) ssq[(size_t)row * 16 + u.pn * 4 + wc] = sq;
            }
            asm volatile("" ::: "memory");
        }
    }
};
struct EpiEvIn {
    static constexpr bool PERM = true;
    bf16_t* P; float* Z; const float* ssq;
    typedef RstdRaw Raw;
    __device__ __forceinline__ void pre_issue(const Unit& u, int wr, int fr, int fq, Raw& r) const { rstd_issue(ssq, u.pm, r); }
    __device__ __forceinline__ void pre_finish(const Raw& r, LAS float* dst, int wr, int wc, int fr, int fq) const { rstd_finish(r, dst); }
    __device__ __forceinline__ void operator()(const f32x4 (&acc)[2][2][4][2], const Unit& u, int wr, int wc, int fr, int fq, const LAS float* rl) const {
        const int row0 = u.pm * 256 + wr * 64 + fr, col0 = u.pn * 256 + wc * 32 + 8 * fq;
        const int pn = u.pn;
        float rsa[2][4];
#pragma unroll
        for (int ai = 0; ai < 2; ++ai)
#pragma unroll
            for (int m = 0; m < 4; ++m) rsa[ai][m] = rl[ai * 128 + wr * 64 + m * 16 + fr];
#pragma unroll
        for (int ai = 0; ai < 2; ++ai)
#pragma unroll
            for (int m = 0; m < 4; ++m) {
                const int row = row0 + ai * 128 + m * 16; const float rs = rsa[ai][m];
                if (pn == 10) {
                    if (wc == 0 && fq < 2) {
                        *(f32x4*)(Z + (size_t)row * 16 + 8 * fq) = acc[ai][0][m][0] * rs;
                        *(f32x4*)(Z + (size_t)row * 16 + 8 * fq + 4) = acc[ai][0][m][1] * rs;
                    }
                } else {
#pragma unroll
                    for (int bj = 0; bj < 2; ++bj) {
                        f32x2 X2[4];
#pragma unroll
                        for (int n = 0; n < 2; ++n) { const f32x4 a = acc[ai][bj][m][n] * rs; X2[2 * n] = (f32x2){a.x, a.y}; X2[2 * n + 1] = (f32x2){a.z, a.w}; }
                        if (pn == 0) {
#pragma unroll
                            for (int q = 0; q < 4; ++q) X2[q] = X2[q] * 0.125f;
                        } else if (pn >= 4) {
                            f32x2 E2[4];
#pragma unroll
                            for (int q = 0; q < 4; ++q) { f32x2 t = X2[q];
                                if (pn >= 6) t = t * ((t * t) * (0.044715f * 1.5957691216057308f) + 1.5957691216057308f);
                                t = t * (-1.4426950408889634f);
                                E2[q].x = __builtin_amdgcn_exp2f(t.x); E2[q].y = __builtin_amdgcn_exp2f(t.y); }
#pragma unroll
                            for (int q = 0; q < 4; ++q) { const f32x2 d = E2[q] + 1.0f; E2[q].x = __builtin_amdgcn_rcpf(d.x); E2[q].y = __builtin_amdgcn_rcpf(d.y); }
#pragma unroll
                            for (int q = 0; q < 4; ++q) X2[q] = X2[q] * E2[q];
                        }
                        u32x4 w; w.x = cvt_pk_bf16(X2[0].x, X2[0].y); w.y = cvt_pk_bf16(X2[1].x, X2[1].y); w.z = cvt_pk_bf16(X2[2].x, X2[2].y); w.w = cvt_pk_bf16(X2[3].x, X2[3].y);
                        st16_wt(P + (size_t)row * PEV_LD + col0 + bj * 128, w);
                    }
                }
            }
    }
};
struct EpiOdIn {
    static constexpr bool PERM = true;
    bf16_t* P; float* out; const float* ssq;
    typedef RstdRaw Raw;
    __device__ __forceinline__ void pre_issue(const Unit& u, int wr, int fr, int fq, Raw& r) const { rstd_issue(ssq, u.pm, r); }
    __device__ __forceinline__ void pre_finish(const Raw& r, LAS float* dst, int wr, int wc, int fr, int fq) const { rstd_finish(r, dst); }
    __device__ __forceinline__ void operator()(const f32x4 (&acc)[2][2][4][2], const Unit& u, int wr, int wc, int fr, int fq, const LAS float* rl) const {
        const int row0 = u.pm * 256 + wr * 64 + fr;
        const int pn = u.pn;
        float rsa[2][4];
#pragma unroll
        for (int ai = 0; ai < 2; ++ai)
#pragma unroll
            for (int m = 0; m < 4; ++m) rsa[ai][m] = rl[ai * 128 + wr * 64 + m * 16 + fr];
#pragma unroll
        for (int ai = 0; ai < 2; ++ai)
#pragma unroll
            for (int m = 0; m < 4; ++m) {
                const int row = row0 + ai * 128 + m * 16; const float rs = rsa[ai][m];
                const int t = row & 2047, b = row >> 11;
                if (pn < 4) {
                    const int col = pn * 128 + wc * 32 + 8 * fq;
                    float v[8];
                    {
                        const float cexp = -1.4426950408889634f * rs;
                        f32x2 E2[4], V2[4];
#pragma unroll
                        for (int n = 0; n < 2; ++n) { const f32x4 g = acc[ai][1][m][n] * cexp;
                            E2[2 * n].x = __builtin_amdgcn_exp2f(g.x); E2[2 * n].y = __builtin_amdgcn_exp2f(g.y); E2[2 * n + 1].x = __builtin_amdgcn_exp2f(g.z); E2[2 * n + 1].y = __builtin_amdgcn_exp2f(g.w); }
#pragma unroll
                        for (int q = 0; q < 4; ++q) { const f32x2 d = E2[q] + 1.0f; E2[q].x = __builtin_amdgcn_rcpf(d.x); E2[q].y = __builtin_amdgcn_rcpf(d.y); }
#pragma unroll
                        for (int n = 0; n < 2; ++n) { const f32x4 a = acc[ai][0][m][n] * rs; V2[2 * n] = (f32x2){a.x, a.y} * E2[2 * n]; V2[2 * n + 1] = (f32x2){a.z, a.w} * E2[2 * n + 1]; }
#pragma unroll
                        for (int q = 0; q < 4; ++q) { v[2 * q] = V2[q].x; v[2 * q + 1] = V2[q].y; }
                    }
                    u32x4 w; w.x = cvt_pk_bf16(v[0], v[1]); w.y = cvt_pk_bf16(v[2], v[3]); w.z = cvt_pk_bf16(v[4], v[5]); w.w = cvt_pk_bf16(v[6], v[7]);
                    *(u32x4*)(P + (size_t)row * POD_LD + col) = w;
                    float* o = nullptr;
                    if (row < MP) { if (t >= SEQ - 30) o = out + O_CONVP + ((size_t)(b * 30 + t - (SEQ - 30))) * 512 + col; }
                    else if (row < MT) o = out + O_CONVS + ((size_t)((row - MP) * 30 + 29)) * 512 + col;
                    if (o) { *(f32x4*)o = (f32x4){v[0], v[1], v[2], v[3]}; *(f32x4*)(o + 4) = (f32x4){v[4], v[5], v[6], v[7]}; }
                } else {
#pragma unroll
                    for (int bj = 0; bj < 2; ++bj) {
                        const int col = (pn - 4) * 256 + bj * 128 + wc * 32 + 8 * fq;
                        const f32x4 v0 = acc[ai][bj][m][0] * rs, v1 = acc[ai][bj][m][1] * rs;
                        u32x4 w; w.x = cvt_pk_bf16(v0.x, v0.y); w.y = cvt_pk_bf16(v0.z, v0.w); w.z = cvt_pk_bf16(v1.x, v1.y); w.w = cvt_pk_bf16(v1.z, v1.w);
                        *(u32x4*)(P + (size_t)row * POD_LD + 512 + col) = w;
                        float* o = nullptr;
                        if (row < MP) { if (t >= SEQ - 15) o = out + O_POOLP + ((size_t)(b * 15 + t - (SEQ - 15))) * 512 + col; }
                        else if (row < MT) o = out + O_POOLS + ((size_t)((row - MP) * 15 + 14)) * 512 + col;
                        if (o) { *(f32x4*)o = v0; *(f32x4*)(o + 4) = v1; }
                    }
                }
            }
    }
};
struct EpiPool {
    static constexpr bool PERM = true;
    bf16_t* MIX; const float* scale;
    __device__ __forceinline__ void operator()(const f32x4 (&acc)[2][2][4][2], const Unit& u, int wr, int wc, int fr, int fq) const {
        const int row0 = u.pm * 256 + wr * 64 + fr, col0 = u.pn * 256 + wc * 32 + 8 * fq;
#pragma unroll
        for (int bj = 0; bj < 2; ++bj) {
            const int col = col0 + bj * 128;
            const f32x4 s0 = *(const f32x4*)(scale + col), s1 = *(const f32x4*)(scale + col + 4);
#pragma unroll
            for (int ai = 0; ai < 2; ++ai)
#pragma unroll
                for (int m = 0; m < 4; ++m) {
                    const int row = row0 + ai * 128 + m * 16;
                    const f32x4 v0 = acc[ai][bj][m][0] * s0, v1 = acc[ai][bj][m][1] * s1;
                    u32x4 w; w.x = cvt_pk_bf16(v0.x, v0.y); w.y = cvt_pk_bf16(v0.z, v0.w); w.z = cvt_pk_bf16(v1.x, v1.y); w.w = cvt_pk_bf16(v1.z, v1.w);
                    *(u32x4*)(MIX + (size_t)row * D + 512 + col) = w;
                }
        }
    }
};

__device__ __forceinline__ int colmap(int mode, int n) {
    if (mode == 0) return n;
    if (mode == 1) { const int pn = n >> 8, j = n & 255; return j < 128 ? 128 * pn + j : 2816 + 128 * pn + (j - 128); }
    if (mode == 2) { return n < 1536 ? n : (n < 2560 ? n + 16 : (n < 2576 ? n - 1024 : -1)); }
    if (n < 1024) { const int pn = n >> 8, j = n & 255; return j < 128 ? 128 * pn + j : 512 + 128 * pn + (j - 128); }
    return n;
}
__device__ __forceinline__ void tr_item(const float* W, int ldw, int srccol4, const float* gain, bf16_t* dst, int K, LAS float* scr, int lane) {
    const int kl = lane >> 4, n4 = (lane & 15) * 4;
    f32x4 v[16];
#pragma unroll
    for (int i = 0; i < 16; ++i) { const int kk = 4 * i + kl; v[i] = (srccol4 >= 0) ? *(const f32x4*)(W + (size_t)kk * ldw + srccol4) : (f32x4){0.f, 0.f, 0.f, 0.f}; }
#pragma unroll
    for (int i = 0; i < 16; ++i) { const int kk = 4 * i + kl; f32x4 x = v[i]; if (gain) x *= gain[kk];
        LAS float* d = scr + kk * 65 + n4; d[0] = x.x; d[1] = x.y; d[2] = x.z; d[3] = x.w; }
    LDS_WAIT();
    const int c = lane & 7;
#pragma unroll
    for (int j = 0; j < 8; ++j) { const int n = (lane >> 3) + 8 * j; const LAS float* s = scr + (8 * c) * 65 + n;
        u32x4 o; o.x = cvt_pk_bf16(s[0 * 65], s[1 * 65]); o.y = cvt_pk_bf16(s[2 * 65], s[3 * 65]); o.z = cvt_pk_bf16(s[4 * 65], s[5 * 65]); o.w = cvt_pk_bf16(s[6 * 65], s[7 * 65]);
        st16_wt(dst + (size_t)(n) * K + 8 * c, o); }
    LDS_WAIT();
}
__device__ __forceinline__ void prep_one(const Params& p, int it, LAS float* scr, int lane) {
    const float* norm_g = p.in[5];
    const float* W; int K, Np, ldw, mode; const float* gain = nullptr; bf16_t* Bt; int r = it;
    if (r < 5632) { const int idx = r / 1408; r -= idx * 1408; const int l = idx >> 1, j = idx & 1;
        W = p.in[6] + (size_t)idx * 1024 * 5632; K = 1024; Np = 5632; ldw = 5632; mode = 1; gain = norm_g + (l * 3 + (j ? 2 : 0)) * 1024; Bt = (bf16_t*)(p.ws + WS_WFFIN) + (size_t)idx * 5632 * 1024; }
    else if (r < 8448) { r -= 5632; const int idx = r / 704; r -= idx * 704;
        W = p.in[7] + (size_t)idx * 2816 * 1024; K = 2816; Np = 1024; ldw = 1024; mode = 0; Bt = (bf16_t*)(p.ws + WS_WFFOUT) + (size_t)idx * 1024 * 2816; }
    else if (r < 9152) { r -= 8448; W = p.in[8]; K = 1024; Np = 2816; ldw = 2576; mode = 2; gain = norm_g + 1 * 1024; Bt = (bf16_t*)(p.ws + WS_WEVIN); }
    else if (r < 9408) { r -= 9152; W = p.in[16]; K = 1024; Np = 1024; ldw = 1024; mode = 0; Bt = (bf16_t*)(p.ws + WS_WEVOUT); }
    else if (r < 9792) { r -= 9408; W = p.in[17]; K = 1024; Np = 1536; ldw = 1536; mode = 3; gain = norm_g + 4 * 1024; Bt = (bf16_t*)(p.ws + WS_WODIN); }
    else if (r < 10048) { r -= 9792; W = p.in[24]; K = 1024; Np = 1024; ldw = 1024; mode = 0; Bt = (bf16_t*)(p.ws + WS_WODOUT); }
    else { r -= 10048; W = p.in[22]; K = 512; Np = 512; ldw = 128; mode = 4; Bt = (bf16_t*)(p.ws + WS_WPOOL); }
    const int nblk = Np / 64, kb = r / nblk, nb = r % nblk, k0 = 64 * kb, n0 = 64 * nb;
    int sc; const float* Wp;
    if (mode == 4) { const int gk = k0 >> 7, gn = n0 >> 7; sc = (gk == gn) ? (n0 & 127) + (lane & 15) * 4 : -1; Wp = W + (size_t)gk * 16384 + (size_t)(k0 & 127) * 128; }
    else { sc = colmap(mode, n0 + (lane & 15) * 4); Wp = W + (size_t)k0 * ldw; }
    tr_item(Wp, ldw, sc, gain ? gain + k0 : nullptr, Bt + (size_t)n0 * K + k0, K, scr, lane);
}
__device__ __forceinline__ void prep_range(const Params& p, LAS unsigned char* L, int lo, int hi, int wi, int nw) {
    const int lane = threadIdx.x & 63, wave = threadIdx.x >> 6;
    LAS float* scr = (LAS float*)(L + wave * 16640);
    for (int it = lo + wi; it < hi; it += nw) prep_one(p, it, scr, lane);
}
__device__ __forceinline__ void tail_prep(const Params& p, LAS unsigned char* L, int nwg, int lo1, int hi1, int lo2, int hi2) {
    const int G = gridDim.x, rem = nwg % G, bx = blockIdx.x, wave = threadIdx.x >> 6;
    int wi, nw;
    if (rem == 0) { wi = bx * 8 + wave; nw = G * 8; } else { if (bx < rem) return; wi = (bx - rem) * 8 + wave; nw = (G - rem) * 8; }
    prep_range(p, L, lo1, hi1, wi, nw);
    prep_range(p, L, lo2, hi2, wi, nw);
}
__device__ __forceinline__ void phase_prep(const Params& p, LAS unsigned char* L) {
    const int tid = threadIdx.x, lane = tid & 63, wave = tid >> 6;
    const int gw = blockIdx.x * 8 + wave, NGW = gridDim.x * 8;
    prep_range(p, L, 0, 1408, gw, NGW);
    bf16_t* XB = (bf16_t*)(p.ws + WS_XB); float* ssq = (float*)(p.ws + WS_SSQ);
    for (int row = gw; row < MPAD; row += NGW) {
        float s = 0.f;
        if (row < MT) {
            const float* src = row < MP ? p.in[0] + (size_t)row * D : p.in[1] + (size_t)(row - MP) * D;
            f32x4 xv[4];
#pragma unroll
            for (int j = 0; j < 2; ++j) { xv[2 * j] = *(const f32x4*)(src + 8 * lane + 512 * j); xv[2 * j + 1] = *(const f32x4*)(src + 8 * lane + 512 * j + 4); }
#pragma unroll
            for (int j = 0; j < 2; ++j) { const f32x4 a = xv[2 * j], c = xv[2 * j + 1];
                s += ((a.x * a.x + a.y * a.y) + (a.z * a.z + a.w * a.w)) + ((c.x * c.x + c.y * c.y) + (c.z * c.z + c.w * c.w));
                u32x4 w; w.x = cvt_pk_bf16(a.x, a.y); w.y = cvt_pk_bf16(a.z, a.w); w.z = cvt_pk_bf16(c.x, c.y); w.w = cvt_pk_bf16(c.z, c.w);
                st16_wt(XB + (size_t)row * D + 8 * lane + 512 * j, w); }
            s = wave_sum(s);
        } else {
#pragma unroll
            for (int j = 0; j < 2; ++j) st16_wt(XB + (size_t)row * D + 8 * lane + 512 * j, (u32x4){0u, 0u, 0u, 0u});
        }
        if (lane < 16) ssq[(size_t)row * 16 + lane] = (lane == 0) ? s : 0.f;
    }
}

__device__ __forceinline__ void gla_cum(const Params& p, int h, int t0, LAS float* cum, LAS float* zs, LAS float* wgs, LAS float* bgs, LAS float* seg) {
    const int tid = threadIdx.x;
    const float* zb = (const float*)(p.ws + WS_Z);
    for (int i = tid; i < 1024; i += 512) zs[i] = zb[(size_t)t0 * 16 + i];
    for (int i = tid; i < 1024; i += 512) { const int r = i >> 6, k = i & 63; wgs[i] = p.in[9][r * 256 + h * 64 + k]; }
    if (tid < 64) bgs[tid] = p.in[10][h * 64 + tid];
    __syncthreads();
    const int kk = tid & 63, sg = tid >> 6;
    float wv[16];
#pragma unroll
    for (int r = 0; r < 16; ++r) wv[r] = wgs[r * 64 + kk];
    const float bb = bgs[kk];
    float run = 0.f, loc[8];
#pragma unroll
    for (int i = 0; i < 8; ++i) { const int s = sg * 8 + i; float g = bb;
#pragma unroll
        for (int r = 0; r < 16; ++r) g += zs[s * 16 + r] * wv[r];
        const float la = (fminf(g, 0.f) - __logf(1.f + __expf(-fabsf(g)))) * (1.f / 16.f);
        run += la; loc[i] = run; }
    seg[sg * 64 + kk] = run;
    __syncthreads();
    float off = 0.f;
#pragma unroll
    for (int j = 0; j < 8; ++j) if (j < sg) off += seg[j * 64 + kk];
#pragma unroll
    for (int i = 0; i < 8; ++i) cum[(sg * 8 + i) * 65 + kk] = off + loc[i];
    __syncthreads();
}
__device__ __forceinline__ f32x4 mma16(const LAS bf16_t* A, int pa, const LAS bf16_t* B, int pb, int ksteps, f32x4 acc, int fr, int fq) {
#pragma unroll
    for (int ks = 0; ks < ksteps; ++ks) {
        const bf16x8 a = *(const LAS bf16x8*)(A + fr * pa + ks * 32 + fq * 8);
        const bf16x8 b = *(const LAS bf16x8*)(B + fr * pb + ks * 32 + fq * 8);
        acc = __builtin_amdgcn_mfma_f32_16x16x32_bf16(a, b, acc, 0, 0, 0);
    }
    return acc;
}
constexpr int PT = 72;
__device__ __forceinline__ void stage_vt(const bf16_t* pev, int t0, int h, LAS bf16_t* Vt) {
    for (int i = threadIdx.x; i < 1024; i += 512) { const int sI = i >> 4, c8 = (i & 15) * 8;
        const u32x4 w = *(const u32x4*)(pev + (size_t)(t0 + sI) * PEV_LD + 512 + h * 128 + c8);
        const unsigned ww[4] = {w.x, w.y, w.z, w.w};
#pragma unroll
        for (int j = 0; j < 4; ++j) { Vt[(c8 + 2 * j) * PT + sI] = (bf16_t)(ww[j] & 0xffffu); Vt[(c8 + 2 * j + 1) * PT + sI] = (bf16_t)(ww[j] >> 16); } }
}
__device__ __forceinline__ void gla_a_item(const Params& p, LAS unsigned char* L, int item) {
    const int tid = threadIdx.x, wave = tid >> 6, lane = tid & 63, fr = lane & 15, fq = lane >> 4;
    const int b = item >> 7, h = (item >> 5) & 3, c = item & 31, t0 = b * SEQ + c * 64;
    LAS float* cum = (LAS float*)L; LAS bf16_t* Kt = (LAS bf16_t*)(cum + 4160); LAS bf16_t* Vt = Kt + 64 * PT;
    LAS float* zs = (LAS float*)(Vt + 128 * PT); LAS float* wgs = zs + 1024; LAS float* bgs = wgs + 1024; LAS float* seg = bgs + 64;
    gla_cum(p, h, t0, cum, zs, wgs, bgs, seg);
    const bf16_t* pev = (const bf16_t*)(p.ws + WS_H);
    {
        const int kk = tid & 63, sg = tid >> 6;
        const float last = cum[63 * 65 + kk];
        float* cb = (float*)(p.ws + WS_X) + (size_t)item * 4096;
        float kv[8];
#pragma unroll
        for (int i = 0; i < 8; ++i) { const int sI = sg * 8 + i; const float cm = cum[sI * 65 + kk]; cb[sI * 64 + kk] = cm;
            kv[i] = bf1(pev[(size_t)(t0 + sI) * PEV_LD + 256 + h * 64 + kk]) * __expf(last - cm); }
        u32x4 w; w.x = cvt_pk_bf16(kv[0], kv[1]); w.y = cvt_pk_bf16(kv[2], kv[3]); w.z = cvt_pk_bf16(kv[4], kv[5]); w.w = cvt_pk_bf16(kv[6], kv[7]);
        *(LAS u32x4*)(Kt + kk * PT + sg * 8) = w;
        if (tid < 64) ((float*)(p.ws + WS_DEC))[(size_t)item * 64 + tid] = __expf(last);
    }
    stage_vt(pev, t0, h, Vt);
    __syncthreads();
    float* KV = (float*)(p.ws + WS_KV) + (size_t)item * 8192;
#pragma unroll
    for (int kt = 0; kt < 4; ++kt) {
        const f32x4 acc = mma16(Kt + kt * 16 * PT, PT, Vt + wave * 16 * PT, PT, 2, (f32x4){0.f, 0.f, 0.f, 0.f}, fr, fq);
#pragma unroll
        for (int j = 0; j < 4; ++j) KV[(kt * 16 + fq * 4 + j) * 128 + wave * 16 + fr] = acc[j];
    }
    __syncthreads();
}
__device__ __forceinline__ void gla_scan_item(const Params& p, int item) {
    const int bh = item >> 4, e = (item & 15) * 512 + threadIdx.x, k = e >> 7;
    float* KV = (float*)(p.ws + WS_KV); const float* dec = (const float*)(p.ws + WS_DEC);
    float S = 0.f, kvv[32], dd[32];
#pragma unroll
    for (int c = 0; c < 32; ++c) { const size_t it = (size_t)bh * 32 + c; kvv[c] = KV[it * 8192 + e]; dd[c] = dec[it * 64 + k]; }
    bf16_t* Sb = (bf16_t*)(p.ws + WS_X + (16u << 20));
#pragma unroll
    for (int c = 0; c < 32; ++c) { const size_t it = (size_t)bh * 32 + c; Sb[it * 8192 + e] = (bf16_t)(cvt_pk_bf16(S, 0.f) & 0xffffu); S = dd[c] * S + kvv[c]; }
    p.out[O_GLAP + (size_t)bh * 8192 + e] = S;
}
__device__ __forceinline__ void gla_c_item(const Params& p, LAS unsigned char* L, int item) {
    const int tid = threadIdx.x, wave = tid >> 6, lane = tid & 63, fr = lane & 15, fq = lane >> 4;
    const int b = item >> 7, h = (item >> 5) & 3, c = item & 31, t0 = b * SEQ + c * 64;
    LAS bf16_t* Qs = (LAS bf16_t*)L; LAS bf16_t* Ks = Qs + 64 * PT; LAS bf16_t* Ps = Ks + 64 * PT; LAS bf16_t* Vt = Ps + 64 * PT; LAS bf16_t* St = Vt + 128 * PT;
    LAS float* Os = (LAS float*)Vt;
    const bf16_t* pev = (const bf16_t*)(p.ws + WS_H);
    const int vq8 = tid & 15, tq2 = tid >> 4;
    u32x4 rwv[2];
#pragma unroll
    for (int i = 0; i < 2; ++i) rwv[i] = *(const u32x4*)(pev + (size_t)(t0 + 2 * tq2 + i) * PEV_LD + 1024 + h * 128 + 8 * vq8);
    {
        const int sI = tid & 63, kg = tid >> 6;
        const u32x4 qw = *(const u32x4*)(pev + (size_t)(t0 + sI) * PEV_LD + h * 64 + kg * 8);
        const u32x4 kw = *(const u32x4*)(pev + (size_t)(t0 + sI) * PEV_LD + 256 + h * 64 + kg * 8);
        const float* cb = (const float*)(p.ws + WS_X) + (size_t)item * 4096 + sI * 64 + kg * 8;
        const f32x4 c0 = *(const f32x4*)cb, c1 = *(const f32x4*)(cb + 4);
        const float cm[8] = {c0.x, c0.y, c0.z, c0.w, c1.x, c1.y, c1.z, c1.w};
        const float qv[8] = {bf_lo(qw.x), bf_hi(qw.x), bf_lo(qw.y), bf_hi(qw.y), bf_lo(qw.z), bf_hi(qw.z), bf_lo(qw.w), bf_hi(qw.w)};
        const float kv[8] = {bf_lo(kw.x), bf_hi(kw.x), bf_lo(kw.y), bf_hi(kw.y), bf_lo(kw.z), bf_hi(kw.z), bf_lo(kw.w), bf_hi(kw.w)};
        float qe[8], ke[8];
#pragma unroll
        for (int i = 0; i < 8; ++i) { qe[i] = qv[i] * __expf(cm[i]); ke[i] = kv[i] * __expf(-cm[i]); }
        u32x4 w; w.x = cvt_pk_bf16(qe[0], qe[1]); w.y = cvt_pk_bf16(qe[2], qe[3]); w.z = cvt_pk_bf16(qe[4], qe[5]); w.w = cvt_pk_bf16(qe[6], qe[7]);
        *(LAS u32x4*)(Qs + sI * PT + kg * 8) = w;
        w.x = cvt_pk_bf16(ke[0], ke[1]); w.y = cvt_pk_bf16(ke[2], ke[3]); w.z = cvt_pk_bf16(ke[4], ke[5]); w.w = cvt_pk_bf16(ke[6], ke[7]);
        *(LAS u32x4*)(Ks + sI * PT + kg * 8) = w;
    }
    stage_vt(pev, t0, h, Vt);
    {
        const bf16_t* Sb = (const bf16_t*)(p.ws + WS_X + (16u << 20)) + (size_t)item * 8192;
        for (int i = tid; i < 1024; i += 512) { const int k = i >> 4, v8 = (i & 15) * 8; const u32x4 x = *(const u32x4*)(Sb + k * 128 + v8);
            const unsigned ww[4] = {x.x, x.y, x.z, x.w};
#pragma unroll
            for (int j = 0; j < 4; ++j) { St[(v8 + 2 * j) * PT + k] = (bf16_t)(ww[j] & 0xffffu); St[(v8 + 2 * j + 1) * PT + k] = (bf16_t)(ww[j] >> 16); } }
    }
    __syncthreads();
    {
        const int tt = wave >> 1;
#pragma unroll
        for (int si = 0; si < 2; ++si) { const int st = (wave & 1) * 2 + si;
            const f32x4 acc = mma16(Qs + tt * 16 * PT, PT, Ks + st * 16 * PT, PT, 2, (f32x4){0.f, 0.f, 0.f, 0.f}, fr, fq);
#pragma unroll
            for (int j = 0; j < 4; ++j) { const int t = tt * 16 + fq * 4 + j, sI = st * 16 + fr; const float v = (sI <= t) ? acc[j] : 0.f;
                Ps[t * PT + sI] = (bf16_t)(cvt_pk_bf16(v, 0.f) & 0xffffu); } }
    }
    __syncthreads();
    f32x4 oacc[4];
#pragma unroll
    for (int tt = 0; tt < 4; ++tt) {
        f32x4 a = mma16(Qs + tt * 16 * PT, PT, St + wave * 16 * PT, PT, 2, (f32x4){0.f, 0.f, 0.f, 0.f}, fr, fq);
        oacc[tt] = mma16(Ps + tt * 16 * PT, PT, Vt + wave * 16 * PT, PT, 2, a, fr, fq);
    }
    __syncthreads();
#pragma unroll
    for (int tt = 0; tt < 4; ++tt)
#pragma unroll
        for (int j = 0; j < 4; ++j) Os[(tt * 16 + fq * 4 + j) * 132 + wave * 16 + fr] = oacc[tt][j];
    __syncthreads();
    bf16_t* mix = (bf16_t*)(p.ws + WS_MIX);
    const f32x4 ga = *(const f32x4*)(p.in[11] + h * 128 + 8 * vq8), gb = *(const f32x4*)(p.in[11] + h * 128 + 8 * vq8 + 4);
#pragma unroll
    for (int i = 0; i < 2; ++i) {
        const int t = 2 * tq2 + i;
        const f32x4 a = *(const LAS f32x4*)(Os + t * 132 + 8 * vq8), c = *(const LAS f32x4*)(Os + t * 132 + 8 * vq8 + 4);
        float ss = ((a.x * a.x + a.y * a.y) + (a.z * a.z + a.w * a.w)) + ((c.x * c.x + c.y * c.y) + (c.z * c.z + c.w * c.w));
#pragma unroll
        for (int o = 1; o < 16; o <<= 1) ss += __shfl_xor(ss, o);
        const float rs = rsqrtf(ss * (1.f / 128.f) + EPS);
        const u32x4 rw = rwv[i];
        const f32x4 o0 = a * rs * ga * (f32x4){bf_lo(rw.x), bf_hi(rw.x), bf_lo(rw.y), bf_hi(rw.y)};
        const f32x4 o1 = c * rs * gb * (f32x4){bf_lo(rw.z), bf_hi(rw.z), bf_lo(rw.w), bf_hi(rw.w)};
        u32x4 w; w.x = cvt_pk_bf16(o0.x, o0.y); w.y = cvt_pk_bf16(o0.z, o0.w); w.z = cvt_pk_bf16(o1.x, o1.y); w.w = cvt_pk_bf16(o1.z, o1.w);
        st16_wt(mix + (size_t)(t0 + t) * D + h * 128 + 8 * vq8, w);
    }
    __syncthreads();
}
__device__ __forceinline__ void gla_s_item(const Params& p, LAS unsigned char* L, int item) {
    const int tid = threadIdx.x, seq = item >> 2, h = item & 3, row = MP + seq;
    LAS float* qs = (LAS float*)L; LAS float* ks = qs + 64; LAS float* ds = ks + 64; LAS float* po = ds + 64; LAS float* red = po + 512;
    const bf16_t* pev = (const bf16_t*)(p.ws + WS_H);
    if (tid < 64) {
        const float* z = (const float*)(p.ws + WS_Z) + (size_t)row * 16;
        float g = p.in[10][h * 64 + tid];
#pragma unroll
        for (int r = 0; r < 16; ++r) g += z[r] * p.in[9][r * 256 + h * 64 + tid];
        const float la = (fminf(g, 0.f) - log1pf(__expf(-fabsf(g)))) * (1.f / 16.f);
        ds[tid] = __expf(la);
        qs[tid] = bf1(pev[(size_t)row * PEV_LD + h * 64 + tid]);
        ks[tid] = bf1(pev[(size_t)row * PEV_LD + 256 + h * 64 + tid]);
    }
    __syncthreads();
    const int v = tid & 127, kq = tid >> 7;
    const float vv = bf1(pev[(size_t)row * PEV_LD + 512 + h * 128 + v]);
    const float* S0 = p.in[2] + (size_t)item * 8192; float* S1 = p.out + O_GLAS + (size_t)item * 8192;
    float o = 0.f;
    float s0v[16];
#pragma unroll
    for (int i = 0; i < 16; ++i) s0v[i] = S0[(kq * 16 + i) * 128 + v];
#pragma unroll
    for (int i = 0; i < 16; ++i) { const int k = kq * 16 + i; const float s0 = s0v[i]; const float d = ds[k]; o += qs[k] * d * s0; S1[k * 128 + v] = d * s0 + ks[k] * vv; }
    po[kq * 128 + v] = o;
    __syncthreads();
    float ot = 0.f;
    if (tid < 128) {
        float qk = 0.f;
#pragma unroll 8
        for (int k = 0; k < 64; ++k) qk += qs[k] * ks[k];
        ot = po[v] + po[128 + v] + po[256 + v] + po[384 + v] + qk * vv;
    }
    const float ss = wave_sum(ot * ot);
    if (tid < 128 && (tid & 63) == 0) red[tid >> 6] = ss;
    __syncthreads();
    if (tid < 128) {
        const float rs = rsqrtf((red[0] + red[1]) * (1.f / 128.f) + EPS);
        const float r = bf1(pev[(size_t)row * PEV_LD + 1024 + h * 128 + v]);
        const float ov = ot * rs * p.in[11][h * 128 + v] * r;
        ((bf16_t*)(p.ws + WS_MIX))[(size_t)row * D + h * 128 + v] = (bf16_t)(cvt_pk_bf16(ov, 0.f) & 0xffffu);
    }
    __syncthreads();
}

constexpr int PW = 136;
__device__ __forceinline__ void sg_item(const Params& p, LAS unsigned char* L, int item) {
    const int tid = threadIdx.x, wave = tid >> 6, lane = tid & 63, fr = lane & 15, fq = lane >> 4;
    const int h = item & 3, n = (item >> 2) & 15, b = item >> 6, t0 = b * SEQ + n * 128;
    LAS bf16_t* Wb = (LAS bf16_t*)L; LAS bf16_t* vT = Wb + 128 * PW; LAS float* mu = (LAS float*)(vT + 128 * PW); LAS float* rsd = mu + 128; LAS float* Os = rsd + 128;
    const bf16_t* pev = (const bf16_t*)(p.ws + WS_H);
    u32x4 vw[4], uwv[4]; float bv[4];
    {
        const int d8 = (tid & 15) * 8, sr = tid >> 4, tb = 4 * (tid >> 4);
#pragma unroll
        for (int ps = 0; ps < 4; ++ps) vw[ps] = *(const u32x4*)(pev + (size_t)(t0 + ps * 32 + sr) * PEV_LD + 2048 + h * 128 + d8);
#pragma unroll
        for (int i = 0; i < 4; ++i) { bv[i] = p.in[15][h * 128 + tb + i]; uwv[i] = *(const u32x4*)(pev + (size_t)(t0 + tb + i) * PEV_LD + 1536 + h * 128 + d8); }
    }
    {
        const int q = tid & 3, sI = tid >> 2;
        const bf16_t* src = pev + (size_t)(t0 + sI) * PEV_LD + 2048 + q * 128;
        float sm = 0.f, sq = 0.f;
#pragma unroll 4
        for (int i = 0; i < 16; ++i) { const u32x4 w = *(const u32x4*)(src + 8 * i);
            const float f[8] = {bf_lo(w.x), bf_hi(w.x), bf_lo(w.y), bf_hi(w.y), bf_lo(w.z), bf_hi(w.z), bf_lo(w.w), bf_hi(w.w)};
#pragma unroll
            for (int j = 0; j < 8; ++j) { sm += f[j]; sq += f[j] * f[j]; } }
        sm += __shfl_xor(sm, 1); sm += __shfl_xor(sm, 2); sq += __shfl_xor(sq, 1); sq += __shfl_xor(sq, 2);
        const float mean = sm * (1.f / 512.f), var = fmaxf(sq * (1.f / 512.f) - mean * mean, 0.f);
        if (q == 0) { mu[sI] = mean; rsd[sI] = rsqrtf(var + EPS); }
    }
    for (int i = tid; i < 2048; i += 512) {
        const int t = i >> 4, s8 = (i & 15) * 8;
        const float* wrow = p.in[14] + ((size_t)h * 128 + t) * 128 + s8;
        const f32x4 a = *(const f32x4*)wrow, c = *(const f32x4*)(wrow + 4);
        float f[8] = {a.x, a.y, a.z, a.w, c.x, c.y, c.z, c.w};
#pragma unroll
        for (int j = 0; j < 8; ++j) if (s8 + j > t) f[j] = 0.f;
        u32x4 w; w.x = cvt_pk_bf16(f[0], f[1]); w.y = cvt_pk_bf16(f[2], f[3]); w.z = cvt_pk_bf16(f[4], f[5]); w.w = cvt_pk_bf16(f[6], f[7]);
        *(LAS u32x4*)(Wb + t * PW + s8) = w;
    }
    __syncthreads();
    {
        const int d8 = (tid & 15) * 8, sr = tid >> 4;
        const f32x4 g0 = *(const f32x4*)(p.in[12] + h * 128 + d8), g1 = *(const f32x4*)(p.in[12] + h * 128 + d8 + 4);
        const f32x4 b0 = *(const f32x4*)(p.in[13] + h * 128 + d8), b1 = *(const f32x4*)(p.in[13] + h * 128 + d8 + 4);
#pragma unroll
        for (int ps = 0; ps < 4; ++ps) { const int sI = ps * 32 + sr;
            const u32x4 w = vw[ps];
            const float m = mu[sI], r = rsd[sI];
            const f32x4 x0 = ((f32x4){bf_lo(w.x), bf_hi(w.x), bf_lo(w.y), bf_hi(w.y)} - m) * r * g0 + b0;
            const f32x4 x1 = ((f32x4){bf_lo(w.z), bf_hi(w.z), bf_lo(w.w), bf_hi(w.w)} - m) * r * g1 + b1;
            if (n == 15) { float* o = p.out + O_SGVP + ((size_t)(b * 128 + sI)) * 512 + h * 128 + d8; *(f32x4*)o = x0; *(f32x4*)(o + 4) = x1; }
            const unsigned ww[4] = {cvt_pk_bf16(x0.x, x0.y), cvt_pk_bf16(x0.z, x0.w), cvt_pk_bf16(x1.x, x1.y), cvt_pk_bf16(x1.z, x1.w)};
#pragma unroll
            for (int j = 0; j < 4; ++j) { vT[(d8 + 2 * j) * PW + sI] = (bf16_t)(ww[j] & 0xffffu); vT[(d8 + 2 * j + 1) * PW + sI] = (bf16_t)(ww[j] >> 16); } }
    }
    __syncthreads();
#pragma unroll
    for (int tt = 0; tt < 8; ++tt) {
        const f32x4 acc = mma16(Wb + tt * 16 * PW, PW, vT + wave * 16 * PW, PW, tt / 2 + 1, (f32x4){0.f, 0.f, 0.f, 0.f}, fr, fq);
#pragma unroll
        for (int j = 0; j < 4; ++j) Os[(tt * 16 + fq * 4 + j) * 132 + wave * 16 + fr] = acc[j];
    }
    __syncthreads();
    {
        const int d0 = (tid & 15) * 8, tb = 4 * (tid >> 4);
        bf16_t* mix = (bf16_t*)(p.ws + WS_MIX);
#pragma unroll
        for (int i = 0; i < 4; ++i) { const int t = tb + i; const float bias = bv[i];
            const f32x4 a0 = *(const LAS f32x4*)(Os + t * 132 + d0), a1 = *(const LAS f32x4*)(Os + t * 132 + d0 + 4);
            const u32x4 uw = uwv[i];
            const f32x4 o0 = (a0 + bias) * (f32x4){bf_lo(uw.x), bf_hi(uw.x), bf_lo(uw.y), bf_hi(uw.y)};
            const f32x4 o1 = (a1 + bias) * (f32x4){bf_lo(uw.z), bf_hi(uw.z), bf_lo(uw.w), bf_hi(uw.w)};
            u32x4 w; w.x = cvt_pk_bf16(o0.x, o0.y); w.y = cvt_pk_bf16(o0.z, o0.w); w.z = cvt_pk_bf16(o1.x, o1.y); w.w = cvt_pk_bf16(o1.z, o1.w);
            st16_wt(mix + (size_t)(t0 + t) * D + 512 + h * 128 + d0, w); }
    }
    __syncthreads();
}
__device__ __forceinline__ void sg_s_row(const Params& p, int seq, int lane) {
    const int row = MP + seq, c0 = 8 * lane, h = c0 >> 7;
    const bf16_t* pev = (const bf16_t*)(p.ws + WS_H);
    const u32x4 w = *(const u32x4*)(pev + (size_t)row * PEV_LD + 2048 + c0);
    float f[8] = {bf_lo(w.x), bf_hi(w.x), bf_lo(w.y), bf_hi(w.y), bf_lo(w.z), bf_hi(w.z), bf_lo(w.w), bf_hi(w.w)};
    float sm = 0.f;
#pragma unroll
    for (int j = 0; j < 8; ++j) sm += f[j];
    const float mean = wave_sum(sm) * (1.f / 512.f);
    float sq = 0.f;
#pragma unroll
    for (int j = 0; j < 8; ++j) { f[j] -= mean; sq += f[j] * f[j]; }
    const float rs = rsqrtf(wave_sum(sq) * (1.f / 512.f) + EPS);
    const float w00 = p.in[14][(size_t)h * 16384], b0 = p.in[15][h * 128];
    const u32x4 uw = *(const u32x4*)(pev + (size_t)row * PEV_LD + 1536 + c0);
    const float uf[8] = {bf_lo(uw.x), bf_hi(uw.x), bf_lo(uw.y), bf_hi(uw.y), bf_lo(uw.z), bf_hi(uw.z), bf_lo(uw.w), bf_hi(uw.w)};
    float vnv[8], ov[8];
#pragma unroll
    for (int j = 0; j < 8; ++j) { vnv[j] = f[j] * rs * p.in[12][c0 + j] + p.in[13][c0 + j]; ov[j] = uf[j] * (w00 * vnv[j] + b0); }
    float* so = p.out + O_SGVS + (size_t)seq * 512 + c0;
    *(f32x4*)so = (f32x4){vnv[0], vnv[1], vnv[2], vnv[3]}; *(f32x4*)(so + 4) = (f32x4){vnv[4], vnv[5], vnv[6], vnv[7]};
    u32x4 o; o.x = cvt_pk_bf16(ov[0], ov[1]); o.y = cvt_pk_bf16(ov[2], ov[3]); o.z = cvt_pk_bf16(ov[4], ov[5]); o.w = cvt_pk_bf16(ov[6], ov[7]);
    st16_wt((bf16_t*)(p.ws + WS_MIX) + (size_t)row * D + 512 + c0, o);
}

__device__ __forceinline__ void conv_ln_rows(const Params& p, const LAS float* cout, int ntok, int rowbase, int wave, int lane) {
    const int c0 = 8 * lane;
    const f32x4 g0 = *(const f32x4*)(p.in[20] + c0), g1 = *(const f32x4*)(p.in[20] + c0 + 4);
    const f32x4 b0 = *(const f32x4*)(p.in[21] + c0), b1 = *(const f32x4*)(p.in[21] + c0 + 4);
#pragma unroll 4
    for (int t = wave; t < ntok; t += 8) {
        f32x4 x0 = *(const LAS f32x4*)(cout + t * 512 + c0), x1 = *(const LAS f32x4*)(cout + t * 512 + c0 + 4);
        float sm = (x0.x + x0.y) + (x0.z + x0.w) + (x1.x + x1.y) + (x1.z + x1.w);
        float sq = (x0.x * x0.x + x0.y * x0.y) + (x0.z * x0.z + x0.w * x0.w) + (x1.x * x1.x + x1.y * x1.y) + (x1.z * x1.z + x1.w * x1.w);
#pragma unroll
        for (int o = 1; o < 64; o <<= 1) { sm += __shfl_xor(sm, o); sq += __shfl_xor(sq, o); }
        const float mean = sm * (1.f / 512.f), var = fmaxf(sq * (1.f / 512.f) - mean * mean, 0.f);
        const float rs = rsqrtf(var + EPS);
        x0 = (x0 - mean) * rs * g0 + b0; x1 = (x1 - mean) * rs * g1 + b1;
        u32x4 w; w.x = cvt_pk_bf16(fsilu(x0.x), fsilu(x0.y)); w.y = cvt_pk_bf16(fsilu(x0.z), fsilu(x0.w)); w.z = cvt_pk_bf16(fsilu(x1.x), fsilu(x1.y)); w.w = cvt_pk_bf16(fsilu(x1.z), fsilu(x1.w));
        st16_wt((bf16_t*)(p.ws + WS_MIX) + (size_t)(rowbase + t) * D + c0, w);
    }
}
__device__ __forceinline__ void conv_item(const Params& p, LAS unsigned char* L, int item) {
    const int tid = threadIdx.x, b = item >> 6, tb = (item & 63) * 32;
    LAS unsigned* gin = (LAS unsigned*)L;
    LAS float* cout = (LAS float*)(L + 63488);
    const bf16_t* pod = (const bf16_t*)(p.ws + WS_H);
    {
        u32x4 wst[8];
#pragma unroll
        for (int k = 0; k < 8; ++k) { const int i = tid + 512 * k, r = i >> 6, c8 = (i & 63) * 8, t = tb - 30 + r;
            wst[k] = (u32x4){0u, 0u, 0u, 0u};
            if (i < 62 * 64 && t >= 0) wst[k] = *(const u32x4*)(pod + (size_t)(b * SEQ + t) * POD_LD + c8); }
#pragma unroll
        for (int k = 0; k < 8; ++k) { const int i = tid + 512 * k, r = i >> 6, c8 = (i & 63) * 8;
            if (i < 62 * 64) *(LAS u32x4*)(gin + r * 256 + (c8 >> 1)) = wst[k]; }
    }
    const int cp = tid & 255, half = tid >> 8;
    f32x2 w[31];
#pragma unroll
    for (int j = 0; j < 31; ++j) w[j] = *(const f32x2*)(p.in[18] + j * 512 + 2 * cp);
    const f32x2 bias = *(const f32x2*)(p.in[19] + 2 * cp);
    __syncthreads();
#pragma unroll 1
    for (int g = 0; g < 4; ++g) {
        const int tt = half * 16 + g * 4;
        f32x2 a[4];
#pragma unroll
        for (int i = 0; i < 4; ++i) a[i] = bias;
#pragma unroll
        for (int jj = 0; jj < 34; ++jj) { const unsigned x = gin[(tt + jj) * 256 + cp]; const f32x2 xv = (f32x2){bf_lo(x), bf_hi(x)};
#pragma unroll
            for (int i = 0; i < 4; ++i) { const int j = jj - i; if (j >= 0 && j <= 30) a[i] += w[j] * xv; } }
#pragma unroll
        for (int i = 0; i < 4; ++i) *(LAS f32x2*)(cout + (tt + i) * 512 + 2 * cp) = a[i];
    }
    __syncthreads();
    conv_ln_rows(p, cout, 32, b * SEQ + tb, tid >> 6, tid & 63);
    __syncthreads();
}
__device__ __forceinline__ void conv_s_item(const Params& p, LAS unsigned char* L, int seq) {
    const int c = threadIdx.x;
    LAS float* cout = (LAS float*)L;
    const bf16_t* pod = (const bf16_t*)(p.ws + WS_H);
    const float* st = p.in[3] + (size_t)seq * 30 * 512 + c; float* so = p.out + O_CONVS + (size_t)seq * 30 * 512 + c;
    float xs[30], wv[31];
#pragma unroll
    for (int j = 0; j < 30; ++j) { xs[j] = st[j * 512]; wv[j] = p.in[18][j * 512 + c]; }
    wv[30] = p.in[18][30 * 512 + c];
    float a = p.in[19][c] + wv[30] * bf1(pod[(size_t)(MP + seq) * POD_LD + c]);
#pragma unroll
    for (int j = 0; j < 30; ++j) a += wv[j] * xs[j];
#pragma unroll
    for (int j = 1; j < 30; ++j) so[(j - 1) * 512] = xs[j];
    cout[c] = a;
    __syncthreads();
    conv_ln_rows(p, cout, 1, MP + seq, threadIdx.x >> 6, threadIdx.x & 63);
    __syncthreads();
}
constexpr int PP = 520;
struct PoolB { bf16x8 b[4][4]; float sc[4]; };
__device__ __forceinline__ void pool_loadb(const Params& p, PoolB& B) {
    const int tid = threadIdx.x, wave = tid >> 6, lane = tid & 63, fr = lane & 15, fq = lane >> 4, g = wave >> 1;
    const bf16_t* Wp = (const bf16_t*)(p.ws + WS_WPOOL);
#pragma unroll
    for (int dt = 0; dt < 4; ++dt) { const int col = wave * 64 + dt * 16 + fr; B.sc[dt] = p.in[23][col];
#pragma unroll
        for (int ks = 0; ks < 4; ++ks) B.b[dt][ks] = *(const bf16x8*)(Wp + (size_t)col * 512 + g * 128 + ks * 32 + fq * 8); }
}
template <int NT>
__device__ __forceinline__ void pool_mma(const Params& p, const PoolB& B, const LAS bf16_t* Pd, LAS bf16_t* Ob, int rowbase) {
    const int tid = threadIdx.x, wave = tid >> 6, lane = tid & 63, fr = lane & 15, fq = lane >> 4, g = wave >> 1;
#pragma unroll
    for (int dt = 0; dt < 4; ++dt) {
        const int col = wave * 64 + dt * 16 + fr;
#pragma unroll
        for (int tt = 0; tt < NT / 16; ++tt) {
            f32x4 acc = (f32x4){0.f, 0.f, 0.f, 0.f};
#pragma unroll
            for (int ks = 0; ks < 4; ++ks) { const bf16x8 a = *(const LAS bf16x8*)(Pd + (tt * 16 + fr) * PP + g * 128 + ks * 32 + fq * 8);
                acc = __builtin_amdgcn_mfma_f32_16x16x32_bf16(a, B.b[dt][ks], acc, 0, 0, 0); }
            const unsigned w0 = cvt_pk_bf16(acc[0] * B.sc[dt], acc[1] * B.sc[dt]), w1 = cvt_pk_bf16(acc[2] * B.sc[dt], acc[3] * B.sc[dt]);
            LAS bf16_t* o = Ob + (tt * 16 + fq * 4) * PP + col;
            o[0] = (bf16_t)(w0 & 0xffffu); o[PP] = (bf16_t)(w0 >> 16); o[2 * PP] = (bf16_t)(w1 & 0xffffu); o[3 * PP] = (bf16_t)(w1 >> 16);
        }
    }
    __syncthreads();
    bf16_t* mix = (bf16_t*)(p.ws + WS_MIX);
    for (int i = tid; i < NT * 64; i += 512) { const int r = i >> 6, c8 = (i & 63) * 8;
        st16_wt(mix + (size_t)(rowbase + r) * D + 512 + c8, *(const LAS u32x4*)(Ob + r * PP + c8)); }
}
constexpr int PNT = 64;
template <int WIN>
__device__ __forceinline__ void pool_body(const bf16_t* base, LAS bf16_t* Pd, int tb) {
    float xv[WIN + PNT - 1];
#pragma unroll
    for (int i = 0; i < WIN + PNT - 1; ++i) { const int t = tb - (WIN - 1) + i; xv[i] = (t >= 0) ? bf1(base[(size_t)t * POD_LD]) : 0.f; }
    float s = 0.f;
#pragma unroll
    for (int i = 0; i < WIN - 1; ++i) s += xv[i];
#pragma unroll
    for (int tt = 0; tt < PNT; ++tt) { const float x = xv[WIN - 1 + tt]; s += x; const int t = tb + tt;
        const float inv = (t + 1 < WIN) ? 1.f / (float)(t + 1) : 1.f / (float)WIN;
        const float pv = s * inv - x;
        Pd[tt * PP] = (bf16_t)(cvt_pk_bf16(pv, 0.f) & 0xffffu);
        s -= xv[tt]; }
}
__device__ __forceinline__ void pool_item(const Params& p, LAS unsigned char* L, int item) {
    const int c = threadIdx.x, b = item >> 5, tb = (item & 31) * PNT, g = c >> 7;
    const bf16_t* base = (const bf16_t*)(p.ws + WS_H) + (size_t)(b * SEQ) * POD_LD + 512 + c;
    LAS bf16_t* Pd = (LAS bf16_t*)L; LAS bf16_t* Ob = Pd + PNT * PP;
    PoolB B; pool_loadb(p, B);
    if (g == 0) pool_body<2>(base, Pd + c, tb); else if (g == 1) pool_body<4>(base, Pd + c, tb); else if (g == 2) pool_body<8>(base, Pd + c, tb); else pool_body<16>(base, Pd + c, tb);
#if defined(PROBEP) && PROBEP == 1
    asm volatile("" ::: "memory");
    if (g == 0) pool_body<2>(base, Pd + c, tb); else if (g == 1) pool_body<4>(base, Pd + c, tb); else if (g == 2) pool_body<8>(base, Pd + c, tb); else pool_body<16>(base, Pd + c, tb);
#endif
    __syncthreads();
    pool_mma<PNT>(p, B, Pd, Ob, b * SEQ + tb);
    __syncthreads();
#if defined(PROBEP) && PROBEP == 2
    pool_mma<PNT>(p, B, Pd, Ob, b * SEQ + tb);
    __syncthreads();
#endif
}
__device__ __forceinline__ void pool_s_item(const Params& p, LAS unsigned char* L, int item) {
    const int c = threadIdx.x, win = 2 << (c >> 7);
    LAS bf16_t* Pd = (LAS bf16_t*)L; LAS bf16_t* Ob = Pd + 32 * PP;
    PoolB B; pool_loadb(p, B);
#pragma unroll 1
    for (int q0 = 0; q0 < 16; q0 += 4) {
        float sv[4][15], xq[4];
#pragma unroll
        for (int qq = 0; qq < 4; ++qq) { const int seq = item * 16 + q0 + qq; const float* st = p.in[4] + (size_t)seq * 15 * 512 + c;
            xq[qq] = bf1(((const bf16_t*)(p.ws + WS_H))[(size_t)(MP + seq) * POD_LD + 512 + c]);
#pragma unroll
            for (int j = 0; j < 15; ++j) sv[qq][j] = st[j * 512]; }
#pragma unroll
        for (int qq = 0; qq < 4; ++qq) { const int seq = item * 16 + q0 + qq; float* so = p.out + O_POOLS + (size_t)seq * 15 * 512 + c;
            float tot = xq[qq];
#pragma unroll
            for (int j = 0; j < 15; ++j) { if (j >= 1) so[(j - 1) * 512] = sv[qq][j]; if (15 - j <= win - 1) tot += sv[qq][j]; }
            const float pv = tot / (float)win - xq[qq];
            Pd[(q0 + qq) * PP + c] = (bf16_t)(cvt_pk_bf16(pv, 0.f) & 0xffffu); }
    }
    __syncthreads();
    pool_mma<16>(p, B, Pd, Ob, MP + item * 16);
    __syncthreads();
}

__device__ __forceinline__ void skinny_resid_item(const Params& p, LAS unsigned char* L, const bf16_t* A, const bf16_t* Bt, int K, float scale, const float* xin_s  , int item) {
    const int tid = threadIdx.x, wave = tid >> 6, lane = tid & 63, fr = lane & 15, fq = lane >> 4;
    const int rg = item & 7, cgp = item >> 3;
    const int kw = K >> 3, ksteps = kw >> 5;
    const bf16_t* ap = A + (size_t)(rg * 16 + fr) * K + wave * kw + fq * 8;
    const bf16_t* bp = Bt + (size_t)(cgp * 64 + fr) * K + wave * kw + fq * 8;
    f32x4 acc[4];
#pragma unroll
    for (int n = 0; n < 4; ++n) acc[n] = (f32x4){0.f, 0.f, 0.f, 0.f};
#pragma unroll 6
    for (int ks = 0; ks < ksteps; ++ks) {
        const bf16x8 a = *(const bf16x8*)(ap + ks * 32);
#pragma unroll
        for (int n = 0; n < 4; ++n) { const bf16x8 b = *(const bf16x8*)(bp + (size_t)n * 16 * K + ks * 32); acc[n] = __builtin_amdgcn_mfma_f32_16x16x32_bf16(a, b, acc[n], 0, 0, 0); }
    }
    LAS float* red = (LAS float*)L;
#pragma unroll
    for (int n = 0; n < 4; ++n)
#pragma unroll
        for (int j = 0; j < 4; ++j) red[wave * 1024 + (fq * 4 + j) * 64 + n * 16 + fr] = acc[n][j];
    __syncthreads();
    const int o = tid * 2, r = o >> 6, c = o & 63;
    float s0 = 0.f, s1 = 0.f;
#pragma unroll
    for (int w = 0; w < 8; ++w) { const f32x2 v = *(const LAS f32x2*)(red + w * 1024 + o); s0 += v.x; s1 += v.y; }
    const int lrow = rg * 16 + r, row = MP + lrow, col = cgp * 64 + c;
    unsigned* xbp = (unsigned*)((bf16_t*)(p.ws + WS_XB) + (size_t)row * D + col);
    f32x2 xi;
    if (xin_s) xi = *(const f32x2*)(xin_s + (size_t)lrow * D + col); else { const unsigned w = *xbp; xi = (f32x2){bf_lo(w), bf_hi(w)}; }
    const float x0 = xi.x + scale * s0, x1 = xi.y + scale * s1;
    *xbp = cvt_pk_bf16(x0, x1);
    float sq = x0 * x0 + x1 * x1;
#pragma unroll
    for (int of = 1; of < 32; of <<= 1) sq += __shfl_xor(sq, of);
    if ((tid & 31) == 0) ((float*)(p.ws + WS_SSQ))[(size_t)row * 16 + cgp] = sq;
    __syncthreads();
}

#define XB_TMO      128
#define XB_XCNT(j)  (256  + 64 * (j))
#define XB_XSUB(j)  (1280 + 64 * (j))
#define XB_XGEN(j)  (2304 + 64 * (j))
#define XB_TOP      3328
#define XB_TOPGEN   3392
#define XCD_BAR_WORDS 3456
#define XB_SPIN_CAP (1u << 20)
__device__ __forceinline__ unsigned xb_ld(unsigned* p)              { return __hip_atomic_load(p, __ATOMIC_RELAXED, __HIP_MEMORY_SCOPE_AGENT); }
__device__ __forceinline__ unsigned xb_add(unsigned* p, unsigned v) { return __hip_atomic_fetch_add(p, v, __ATOMIC_RELAXED, __HIP_MEMORY_SCOPE_AGENT); }
__device__ __forceinline__ unsigned xb_xcc_id() { return (unsigned)__builtin_amdgcn_s_getreg((3 << 11) | 20) & 0xFu; }
#define XB_SPIN(cond, bar) do { unsigned _sp = 0; while (cond) { __builtin_amdgcn_s_sleep(1); \
    if ((++_sp & 255u) == 0u) { if (xb_ld(&(bar)[XB_TMO])) break; if (_sp > XB_SPIN_CAP) { atomicAdd(&(bar)[XB_TMO], 1u); break; } } } } while (0)
struct XcdBarrier { unsigned* bar; unsigned x; volatile LAS unsigned* st; };
__device__ __forceinline__ XcdBarrier xcd_barrier_post(unsigned* bar, volatile LAS unsigned* st) {
    XcdBarrier b; b.bar = bar; b.x = xb_xcc_id(); b.st = st;
    if (threadIdx.x == 0) (void)xb_add(&bar[XB_XCNT(b.x)], 1u);
    return b;
}
__device__ __forceinline__ void xcd_barrier_complete(unsigned* bar, unsigned x, unsigned& nloc, unsigned& nx) {
    const unsigned G = gridDim.x * gridDim.y * gridDim.z;
    unsigned sum, cnt, mine, sp = 0u;
    for (;;) {
        sum = 0u; cnt = 0u; mine = 0u;
#pragma unroll
        for (unsigned j = 0; j < 16; ++j) { const unsigned c = xb_ld(&bar[XB_XCNT(j)]); sum += c; cnt += (c > 0u) ? 1u : 0u; mine = (j == x) ? c : mine; }
        if (sum == G) break;
        __builtin_amdgcn_s_sleep(1);
        if ((++sp & 255u) == 0u) { if (xb_ld(&bar[XB_TMO])) break; if (sp > XB_SPIN_CAP) { atomicAdd(&bar[XB_TMO], 1u); break; } }
    }
    nloc = mine > 0u ? mine : 1u; nx = cnt > 0u ? cnt : 1u;
}
__device__ __forceinline__ void xcd_barrier(const XcdBarrier& b) {
    asm volatile("s_waitcnt vmcnt(0)" ::: "memory");
    __syncthreads();
    if (threadIdx.x == 0) {
        unsigned* bar = b.bar;
        __builtin_amdgcn_s_waitcnt(0);
        unsigned nloc = b.st[0], nx = b.st[1];
        if (nloc == 0u) { xcd_barrier_complete(bar, b.x, nloc, nx); b.st[0] = nloc; b.st[1] = nx; }
        const unsigned old = xb_add(&bar[XB_XSUB(b.x)], 1u);
        const unsigned gen = old / nloc;
        if (old + 1u == (gen + 1u) * nloc) {
            __builtin_amdgcn_fence(__ATOMIC_RELEASE, "agent");
            asm volatile("s_waitcnt vmcnt(0)" ::: "memory");
            const unsigned og = xb_add(&bar[XB_TOP], 1u);
            const unsigned tg = og / nx;
            if (og + 1u == (tg + 1u) * nx) xb_add(&bar[XB_TOPGEN], 1u);
            else XB_SPIN(xb_ld(&bar[XB_TOPGEN]) == tg, bar);
            __builtin_amdgcn_fence(__ATOMIC_ACQUIRE, "agent");
            xb_add(&bar[XB_XGEN(b.x)], 1u);
            asm volatile("s_waitcnt vmcnt(0)" ::: "memory");
        } else {
            XB_SPIN(xb_ld(&bar[XB_XGEN(b.x)]) == gen, bar);
            __builtin_amdgcn_fence(__ATOMIC_ACQUIRE, "agent");
            asm volatile("s_waitcnt vmcnt(0)" ::: "memory");
        }
    }
    __syncthreads();
}

__device__ __forceinline__ void ffn_in_phase(const Params& p, LAS unsigned char* L, int idx, int lo1, int hi1, int lo2, int hi2) {
    pg8::Gemm g{(const bf16_t*)(p.ws + WS_XB), (const bf16_t*)(p.ws + WS_WFFIN) + (size_t)idx * 5632 * 1024, MPAD, 5632, 1024};
    pg8::StaticOrder S; S.init(MPAD, 5632, gridDim.x, blockIdx.x);
    EpiFfnIn E{(bf16_t*)(p.ws + WS_H), (const float*)(p.ws + WS_SSQ)};
    pg8::gemm_phase<EpiFfnIn>(L, g, S, E);
    tail_prep(p, L, (MPAD / 256) * 22, lo1, hi1, lo2, hi2);
}
template <bool FIRST>
__device__ __forceinline__ void resid_phase(const Params& p, LAS unsigned char* L, const bf16_t* A, const bf16_t* Bt, int K, float scale) {
    pg8::Gemm g{A, Bt, MP, 1024, K};
    pg8::StaticOrder S; S.init(MP, 1024, gridDim.x, blockIdx.x);
    if (p.dry) scale = 0.f;
    EpiResid<FIRST> E{p.in[0], (bf16_t*)(p.ws + WS_XB), (float*)(p.ws + WS_SSQ), scale};
    pg8::gemm_phase<EpiResid<FIRST>>(L, g, S, E);
    for (int it = (int)gridDim.x - 1 - (int)blockIdx.x; it < 128; it += gridDim.x) skinny_resid_item(p, L, A + (size_t)MP * K, Bt, K, scale, FIRST ? p.in[1] : nullptr, it);
}

__global__ void __launch_bounds__(512, 2) mk_fwd(Params p) {
    extern __shared__ __attribute__((aligned(16))) unsigned char lds_raw[];
    LAS unsigned char* L = (LAS unsigned char*)lds_raw;
    const int tid = threadIdx.x, G = gridDim.x, bx = blockIdx.x;
    const int lo = p.ph_lo, hi = p.ph_hi;
    int ph = 0;
#if MK_MULTI
#define SEAM() do { ++ph; } while (0)
#else
    if (tid < 4) ((LAS unsigned*)(L + LDS_BYTES - 16))[tid] = 0u;
    __syncthreads();
    const XcdBarrier xbar = xcd_barrier_post((unsigned*)(p.ws + WS_BAR), (volatile LAS unsigned*)(L + LDS_BYTES - 16));
    if (p.ph_hi < 0) cg::this_grid().sync();
#define SEAM() do { ++ph; xcd_barrier(xbar); } while (0)
#endif
#define IN() (lo <= ph && ph < hi)
    const bf16_t* XB = (const bf16_t*)(p.ws + WS_XB);
    const bf16_t* Hb = (const bf16_t*)(p.ws + WS_H);
    const bf16_t* MIX = (const bf16_t*)(p.ws + WS_MIX);
    const bf16_t* WFFOUT = (const bf16_t*)(p.ws + WS_WFFOUT);

    if (IN()) phase_prep(p, L);
    SEAM();
    if (IN()) ffn_in_phase(p, L, 0, 5632, 6336, 8448, 9408);
    SEAM();
    if (IN()) resid_phase<true>(p, L, Hb, WFFOUT, DFF, 0.5f);
    SEAM();
    if (IN()) {
        pg8::Gemm g{XB, (const bf16_t*)(p.ws + WS_WEVIN), MPAD, EVN, 1024};
        pg8::StaticOrder S; S.init(MPAD, EVN, G, bx);
        EpiEvIn E{(bf16_t*)(p.ws + WS_H), (float*)(p.ws + WS_Z), (const float*)(p.ws + WS_SSQ)};
        pg8::gemm_phase<EpiEvIn>(L, g, S, E);
        tail_prep(p, L, (MPAD / 256) * 11, 1408, 2816, 0, 0);
    }
    SEAM();
    if (IN()) {
        for (int it = bx; it < 1024; it += G) gla_a_item(p, L, it);
        for (int sl = bx; sl < 512; sl += G) sg_item(p, L, (G & 7) ? sl : (sl & 7) * 64 + (sl >> 3));
        for (int s = bx * 8 + (tid >> 6); s < NS; s += G * 8) sg_s_row(p, s, tid & 63);
    }
    SEAM();
    if (IN()) { for (int it = bx; it < 512; it += G) gla_scan_item(p, it); }
    SEAM();
    if (IN()) {
        for (int it = bx; it < 1024; it += G) gla_c_item(p, L, it);
        for (int it = bx; it < 512; it += G) gla_s_item(p, L, it);
    }
    SEAM();
    if (IN()) resid_phase<false>(p, L, MIX, (const bf16_t*)(p.ws + WS_WEVOUT), 1024, 1.0f);
    SEAM();
    if (IN()) ffn_in_phase(p, L, 1, 6336, 7040, 2816, 4224);
    SEAM();
    if (IN()) resid_phase<false>(p, L, Hb, WFFOUT + (size_t)1 * 1024 * 2816, DFF, 0.5f);
    SEAM();
    if (IN()) ffn_in_phase(p, L, 2, 7040, 7744, 9408, 10112);
    SEAM();
    if (IN()) resid_phase<false>(p, L, Hb, WFFOUT + (size_t)2 * 1024 * 2816, DFF, 0.5f);
    SEAM();
    if (IN()) {
        pg8::Gemm g{XB, (const bf16_t*)(p.ws + WS_WODIN), MPAD, ODN, 1024};
        pg8::StaticOrder S; S.init(MPAD, ODN, G, bx);
        EpiOdIn E{(bf16_t*)(p.ws + WS_H), p.out, (const float*)(p.ws + WS_SSQ)};
        pg8::gemm_phase<EpiOdIn>(L, g, S, E);
        tail_prep(p, L, (MPAD / 256) * 6, 4224, 5632, 0, 0);
    }
    SEAM();
    if (IN()) {
        for (int sl = bx; sl < 512; sl += G) conv_item(p, L, (G & 7) ? sl : (sl & 7) * 64 + (sl >> 3));
#if defined(PROBE13) && PROBE13 == 1
        for (int it = bx; it < 512; it += G) conv_item(p, L, it);
#endif
        for (int it = bx; it < NS; it += G) conv_s_item(p, L, it);
#if defined(PROBE13) && PROBE13 == 3
        for (int it = bx; it < NS; it += G) conv_s_item(p, L, it);
#endif
        for (int sl = bx; sl < 256; sl += G) pool_item(p, L, (G & 7) ? sl : (sl & 7) * 32 + (sl >> 3));
        for (int it = G - 1 - bx; it < 8; it += G) pool_s_item(p, L, it);
    }
    SEAM();
    if (IN()) resid_phase<false>(p, L, MIX, (const bf16_t*)(p.ws + WS_WODOUT), 1024, 1.0f);
    SEAM();
    if (IN()) ffn_in_phase(p, L, 3, 7744, 8448, 0, 0);
    SEAM();
    if (IN()) resid_phase<false>(p, L, Hb, WFFOUT + (size_t)3 * 1024 * 2816, DFF, 0.5f);
    SEAM();
    if (IN()) {
        const int lane = tid & 63; const float* ssq = (const float*)(p.ws + WS_SSQ);
        const f32x4 g0[2] = {*(const f32x4*)(p.in[25] + 8 * lane), *(const f32x4*)(p.in[25] + 8 * lane + 512)};
        const f32x4 g1[2] = {*(const f32x4*)(p.in[25] + 8 * lane + 4), *(const f32x4*)(p.in[25] + 8 * lane + 516)};
        for (int row = bx * 8 + (tid >> 6); row < MT; row += 2 * G * 8) {
            const int row2 = row + G * 8; const bool has2 = row2 < MT; const int r2 = has2 ? row2 : row;
            u32x4 w[2][2]; f32x4 sq[2];
#pragma unroll
            for (int j = 0; j < 2; ++j) { w[0][j] = *(const u32x4*)(XB + (size_t)row * D + 8 * lane + 512 * j); w[1][j] = *(const u32x4*)(XB + (size_t)r2 * D + 8 * lane + 512 * j); }
            sq[0] = *(const f32x4*)(ssq + (size_t)row * 16 + 4 * (lane & 3)); sq[1] = *(const f32x4*)(ssq + (size_t)r2 * 16 + 4 * (lane & 3));
#pragma unroll
            for (int q = 0; q < 2; ++q) {
                float t = (sq[q].x + sq[q].y) + (sq[q].z + sq[q].w); t += __shfl_xor(t, 1); t += __shfl_xor(t, 2);
                const float rs = rsqrtf(t * (1.f / 1024.f) + EPS);
                if (q == 0 || has2) {
                    float* o = p.out + O_Y + (size_t)(q ? r2 : row) * D + 8 * lane;
#pragma unroll
                    for (int j = 0; j < 2; ++j) { const u32x4 x = w[q][j];
                        *(f32x4*)(o + 512 * j) = (f32x4){bf_lo(x.x), bf_hi(x.x), bf_lo(x.y), bf_hi(x.y)} * rs * g0[j];
                        *(f32x4*)(o + 512 * j + 4) = (f32x4){bf_lo(x.z), bf_hi(x.z), bf_lo(x.w), bf_hi(x.w)} * rs * g1[j]; }
                }
            }
        }
    }
#undef IN
#undef SEAM
}
constexpr int N_PHASES = 18;

extern "C" void kernel_launch(void* const* d_in, const int* in_sizes, int n_in, void* d_out, int out_size, void* d_ws, size_t ws_size, hipStream_t stream) {
    static int grid = 0;
    if (grid == 0) {
        if (n_in != 26 || ws_size < WS_END) { fprintf(stderr, "kernel_launch: unexpected n_in %d / ws_size %zu (need %zu)\n", n_in, ws_size, (size_t)WS_END); grid = -1; return; }
        int dev = 0, cus = 0, per_cu = 0;
        hipGetDevice(&dev);
        hipDeviceGetAttribute(&cus, hipDeviceAttributeMultiprocessorCount, dev);
        if (hipFuncSetAttribute((const void*)mk_fwd, hipFuncAttributeMaxDynamicSharedMemorySize, LDS_BYTES) != hipSuccess) { fprintf(stderr, "kernel_launch: hipFuncSetAttribute failed\n"); grid = -1; return; }
        if (hipOccupancyMaxActiveBlocksPerMultiprocessor(&per_cu, (const void*)mk_fwd, 512, LDS_BYTES) != hipSuccess || per_cu < 1) { fprintf(stderr, "kernel_launch: occupancy query gave %d\n", per_cu); per_cu = 1; }
        (void)hipGetLastError();
        grid = cus * per_cu;
        fprintf(stderr, "kernel_launch: grid %d (cus %d x %d)\n", grid, cus, per_cu);
    }
    if (grid < 0) return;
    Params p{};
    for (int i = 0; i < 26; ++i) p.in[i] = (const float*)d_in[i];
    p.out = (float*)d_out; p.ws = (unsigned char*)d_ws;
#if MK_MULTI
    for (int ph = 0; ph < N_PHASES; ++ph) {
        int reps = 1;
#ifdef PROBE_EXTRA
        { const int ex[] = PROBE_EXTRA; for (unsigned i = 0; i < sizeof(ex) / sizeof(int); ++i) if (ex[i] == ph) ++reps; }
#endif
        for (int r = 0; r < reps; ++r) { p.ph_lo = ph; p.ph_hi = ph + 1; p.dry = r; hipLaunchKernelGGL(mk_fwd, dim3(grid), dim3(512), LDS_BYTES, stream, p); }
    }
#else
    p.ph_lo = 0; p.ph_hi = N_PHASES;
    if (hipMemsetAsync((char*)d_ws + WS_BAR, 0, XCD_BAR_WORDS * 4, stream) != hipSuccess) { fprintf(stderr, "kernel_launch: memset failed\n"); return; }
    void* args[] = {&p};
    hipError_t e = hipLaunchCooperativeKernel((const void*)mk_fwd, dim3(grid), dim3(512), args, LDS_BYTES, stream);
    if (e != hipSuccess) fprintf(stderr, "kernel_launch: cooperative launch failed: %s (grid %d)\n", hipGetErrorString(e), grid);
#endif
}
```

```cpp
#include <hip/hip_runtime.h>
#include <hip/hip_cooperative_groups.h>
#include <cstdio>
#include <cstdint>
namespace cg = cooperative_groups;

#define LAS __attribute__((address_space(3)))
typedef unsigned short bf16_t;
typedef short bf16x8 __attribute__((ext_vector_type(8)));
typedef float f32x4 __attribute__((ext_vector_type(4)));
typedef float f32x2 __attribute__((ext_vector_type(2)));
typedef unsigned u32x4 __attribute__((ext_vector_type(4)));
typedef unsigned u32x2 __attribute__((ext_vector_type(2)));

#ifndef MK_MULTI
#define MK_MULTI 0
#endif

constexpr int D = 1024, SEQ = 2048, MP = 16384, NS = 128, MT = 16512, MPAD = 16640, DFF = 2816;
constexpr int EVN = 2816, ODN = 1536, PEV_LD = 2816, POD_LD = 1024;
constexpr float EPS = 1e-6f;
constexpr size_t O_Y = 0, O_GLAP = 16908288, O_GLAS = 17170432, O_SGVP = 21364736, O_SGVS = 21889024,
                 O_CONVP = 21954560, O_CONVS = 22077440, O_POOLP = 24043520, O_POOLS = 24104960;
constexpr size_t WS_WFFIN = 0;
constexpr size_t WS_WFFOUT = WS_WFFIN + 4ull * 11534336;
constexpr size_t WS_WEVIN = WS_WFFOUT + 4ull * 5767168;
constexpr size_t WS_WEVOUT = WS_WEVIN + 5767168;
constexpr size_t WS_WODIN = WS_WEVOUT + 2097152;
constexpr size_t WS_WODOUT = WS_WODIN + 3145728;
constexpr size_t WS_WPOOL = WS_WODOUT + 2097152;
constexpr size_t WS_X = WS_WPOOL + 524288;
constexpr size_t WS_XB = WS_X + 68157440;
constexpr size_t WS_SSQ = WS_XB + 34078720;
constexpr size_t WS_H = WS_SSQ + 1064960;
constexpr size_t WS_Z = WS_H + 93716480;
constexpr size_t WS_MIX = WS_Z + 1064960;
constexpr size_t WS_KV = WS_MIX + 34078720;
constexpr size_t WS_DEC = WS_KV + 33554432;
constexpr size_t WS_BAR = WS_DEC + 262144;
constexpr size_t WS_END = WS_BAR + 16384;
constexpr int LDS_BYTES = 147456;

struct Params {
    const float* in[26];
    float* out;
    unsigned char* ws;
    int ph_lo, ph_hi, dry, pad;
};

typedef __bf16 bf16x2_t __attribute__((ext_vector_type(2)));
__device__ __forceinline__ unsigned cvt_pk_bf16(float lo, float hi) { const f32x2 v = {lo, hi}; const bf16x2_t b = __builtin_convertvector(v, bf16x2_t); return __builtin_bit_cast(unsigned, b); }
__device__ __forceinline__ float bf_lo(unsigned w) { return __uint_as_float(w << 16); }
__device__ __forceinline__ float bf_hi(unsigned w) { return __uint_as_float(w & 0xffff0000u); }
__device__ __forceinline__ float bf1(bf16_t b) { return __uint_as_float(((unsigned)b) << 16); }
__device__ __forceinline__ float wave_sum(float v) {
#pragma unroll
    for (int o = 1; o < 64; o <<= 1) v += __shfl_xor(v, o);
    return v;
}
__device__ __forceinline__ float fsigmoid(float x) { return __builtin_amdgcn_rcpf(1.f + __builtin_amdgcn_exp2f(-1.4426950408889634f * x)); }
__device__ __forceinline__ float fsilu(float x) { return x * fsigmoid(x); }
__device__ __forceinline__ float fgelu(float x) { return x * fsigmoid(1.5957691216057308f * (x + 0.044715f * x * x * x)); }
#define LDS_WAIT() asm volatile("s_waitcnt lgkmcnt(0)" ::: "memory")
__device__ __forceinline__ void st16_wt(void* ptr, u32x4 v) { asm volatile("global_store_dwordx4 %0, %1, off sc1\n\ts_nop 2" :: "v"(ptr), "v"(v) : "memory"); }

namespace pg8 {
constexpr int BM = 256, BK = 64, HALF = 128, HTB = HALF * BK * 2, STAGE_BYTES = 8 * HTB, NXCD = 8, WGM = 8;
__host__ __device__ __forceinline__ int lds_byte(int r, int c) { const int st = (r >> 4) * 2 + (c >> 5), rr = r & 15, cc = c & 31, ob = rr * 64 + cc * 2; return st * 1024 + (ob ^ (((ob >> 9) & 1) << 5)); }
__host__ __device__ __forceinline__ void stage_rc(int b, int& R, int& C) { const int st = b / 1024, sb = b % 1024, swz = sb ^ (((sb >> 9) & 1) << 5); R = (st >> 1) * 16 + swz / 64; C = (st & 1) * 32 + (swz % 64) / 2; }
__host__ __device__ __forceinline__ int perm32(int rho) { const int n = rho >> 4, i = rho & 15; return 8 * (i >> 2) + 4 * n + (i & 3); }
struct Unit { int pm, pn; };
struct Gemm { const bf16_t* A; const bf16_t* Bt; int M, N, K; };
struct StaticOrder {
    int nM, nN, nwg, G, c;
    __host__ __device__ void init(int M, int N, int G_, int c_) { nM = M / BM; nN = N / BM; nwg = nM * nN; G = G_; c = c_; }
    __host__ __device__ bool next(int i, Unit& u) const {
        const long L = (long)i * G + c; if (L >= nwg) return false;
        int wgid = (int)L; { const int q = nwg / NXCD, r = nwg % NXCD, xcd = wgid % NXCD, off = wgid / NXCD; wgid = (xcd < r ? xcd * (q + 1) : r * (q + 1) + (xcd - r) * q) + off; }
        const int nig = WGM * nN, gid = wgid / nig, fm = gid * WGM, gsz = (nM - fm) < WGM ? (nM - fm) : WGM;
        u.pm = fm + ((wgid % nig) % gsz); u.pn = (wgid % nig) / gsz; return true;
    }
};
template <class Epi, bool ALIGN_EPI = true>
__device__ __forceinline__ void gemm_phase(LAS unsigned char* lds, const Gemm g, const StaticOrder& S, const Epi& E) {
    const int tid = threadIdx.x, wid = __builtin_amdgcn_readfirstlane(tid >> 6), lane = tid & 63, wr = wid >> 2, wc = wid & 3, fr = lane & 15, fq = lane >> 4;
    const int K = g.K, nt = K / BK;
    unsigned voffA[2], voffB[2];
#pragma unroll
    for (int i = 0; i < 2; ++i) { int R, C; stage_rc(tid * 16 + i * 8192, R, C); const int Rb = Epi::PERM ? ((R & ~31) + perm32(R & 31)) : R;
        voffA[i] = (unsigned)(R * K + C) * 2u; voffB[i] = (unsigned)(Rb * K + C) * 2u; }
    const size_t kstep = (size_t)(BK * 2);
    const size_t hstep = (size_t)HALF * K * 2;
    const size_t tstep = 2 * hstep;
    const unsigned ldsw = (unsigned)wid * 1024u;
    const int aoff = lds_byte(wr * 64 + fr, fq * 8), boff = lds_byte(wc * 32 + fr, fq * 8);
#define PG8_SA(b, h) (((b) * 2 + (h)) * HTB)
#define PG8_SB(b, h) ((4 + (b) * 2 + (h)) * HTB)
#define PG8_STAGE(bufoff, gbase, voff) do { _Pragma("unroll") for (int _i = 0; _i < 2; ++_i) \
        __builtin_amdgcn_global_load_lds((const unsigned*)((const char*)(gbase) + (voff)[_i]), (LAS unsigned*)(lds + (bufoff) + ldsw + _i * 8192), 16, 0, 0); } while (0)
#define PG8_LDA(dst, b, h) do { _Pragma("unroll") for (int m = 0; m < 4; ++m) _Pragma("unroll") for (int k = 0; k < 2; ++k) dst[m][k] = *(const LAS bf16x8*)(lds + PG8_SA(b, h) + aoff + m * 2048 + k * 1024); } while (0)
#define PG8_LDB(dst, b, h) do { _Pragma("unroll") for (int n = 0; n < 2; ++n) _Pragma("unroll") for (int k = 0; k < 2; ++k) dst[n][k] = *(const LAS bf16x8*)(lds + PG8_SB(b, h) + boff + n * 2048 + k * 1024); } while (0)
#define PG8_MMA(ai, bj, At, Bt) do { __builtin_amdgcn_s_setprio(1); _Pragma("unroll") for (int m = 0; m < 4; ++m) _Pragma("unroll") for (int n = 0; n < 2; ++n) _Pragma("unroll") for (int k = 0; k < 2; ++k) \
        acc[ai][bj][m][n] = __builtin_amdgcn_mfma_f32_16x16x32_bf16(Bt[n][k], At[m][k], acc[ai][bj][m][n], 0, 0, 0); __builtin_amdgcn_s_setprio(0); } while (0)
#define PG8_WAIT_V(n) asm volatile("s_waitcnt vmcnt(" #n ")" ::: "memory")
#define PG8_WAIT_L(n) asm volatile("s_waitcnt lgkmcnt(" #n ")" ::: "memory")
#define PG8_BAR __builtin_amdgcn_s_barrier()
#define PG8_SCHED __builtin_amdgcn_sched_barrier(0)
    Unit cur, nxt; int ui = 0;
    if (!S.next(0, cur)) return;
    LAS float* rl = (LAS float*)(lds + STAGE_BYTES);
    { typename Epi::Raw raw0; E.pre_issue(cur, wr, fr, fq, raw0); E.pre_finish(raw0, rl, wr, wc, fr, fq); }
    f32x4 acc[2][2][4][2];
#pragma unroll
    for (int a = 0; a < 2; ++a)
#pragma unroll
        for (int b = 0; b < 2; ++b)
#pragma unroll
            for (int m = 0; m < 4; ++m)
#pragma unroll
                for (int n = 0; n < 2; ++n) acc[a][b][m][n] = (f32x4){0.f, 0.f, 0.f, 0.f};
    bf16x8 At[4][2], B0[2][2], B1[2][2];
    const char* cA = (const char*)g.A + (size_t)cur.pm * tstep; const char* cB = (const char*)g.Bt + (size_t)cur.pn * tstep;
    PG8_STAGE(PG8_SB(0, 0), cB, voffB); PG8_STAGE(PG8_SB(0, 1), cB + hstep, voffB); PG8_STAGE(PG8_SA(0, 0), cA, voffA); PG8_STAGE(PG8_SA(0, 1), cA + hstep, voffA);
    if (wr == 1) PG8_BAR;
    PG8_WAIT_V(2); PG8_BAR;
    PG8_STAGE(PG8_SB(1, 0), cB + kstep, voffB); PG8_STAGE(PG8_SA(1, 0), cA + kstep, voffA); PG8_STAGE(PG8_SB(1, 1), cB + hstep + kstep, voffB);
    PG8_WAIT_V(6); PG8_BAR;
    for (;;) {
        const bool has_next = S.next(ui + 1, nxt);
        const char* nA = has_next ? (const char*)g.A + (size_t)nxt.pm * tstep : cA; const char* nB = has_next ? (const char*)g.Bt + (size_t)nxt.pn * tstep : cB;
        for (int t = 0; t < nt; t += 2) {
            const bool last = (t == nt - 2);
            const char* a1 = cA + (size_t)(t + 1) * kstep;
            const char* a2 = last ? nA : cA + (size_t)(t + 2) * kstep; const char* b2 = last ? nB : cB + (size_t)(t + 2) * kstep;
            const char* a3 = a2 + kstep; const char* b3 = b2 + kstep;
            PG8_LDB(B0, 0, 0); PG8_LDB(B1, 0, 1); PG8_SCHED; PG8_LDA(At, 0, 0); PG8_STAGE(PG8_SA(1, 1), a1 + hstep, voffA);
            PG8_WAIT_V(8); PG8_WAIT_L(0); PG8_BAR; PG8_MMA(0, 0, At, B0); PG8_MMA(0, 1, At, B1); PG8_BAR; PG8_SCHED;
            PG8_LDA(At, 0, 1); PG8_STAGE(PG8_SB(0, 0), b2, voffB); PG8_STAGE(PG8_SB(0, 1), b2 + hstep, voffB); PG8_STAGE(PG8_SA(0, 0), a2, voffA);
            PG8_WAIT_V(8); PG8_WAIT_L(0); PG8_BAR; PG8_MMA(1, 0, At, B0); PG8_MMA(1, 1, At, B1); PG8_BAR; PG8_SCHED;
            PG8_LDB(B0, 1, 0); PG8_LDB(B1, 1, 1); PG8_SCHED; PG8_LDA(At, 1, 0); PG8_STAGE(PG8_SA(0, 1), a2 + hstep, voffA);
            PG8_WAIT_V(8); PG8_WAIT_L(0); PG8_BAR; PG8_MMA(0, 0, At, B0); PG8_MMA(0, 1, At, B1); PG8_BAR; PG8_SCHED;
            PG8_LDA(At, 1, 1); PG8_STAGE(PG8_SB(1, 0), b3, voffB); PG8_STAGE(PG8_SB(1, 1), b3 + hstep, voffB); PG8_STAGE(PG8_SA(1, 0), a3, voffA);
            PG8_WAIT_V(8); PG8_WAIT_L(0); PG8_BAR; PG8_MMA(1, 0, At, B0); PG8_MMA(1, 1, At, B1); PG8_BAR; PG8_SCHED;
        }
        if constexpr (ALIGN_EPI) { if (wr == 0) PG8_BAR; }
        typename Epi::Raw raw; if (has_next) E.pre_issue(nxt, wr, fr, fq, raw);
        E(acc, cur, wr, wc, fr, fq, rl + (ui & 1) * 256);
        if (has_next) E.pre_finish(raw, rl + ((ui + 1) & 1) * 256, wr, wc, fr, fq);
        if (!has_next) break;
#pragma unroll
        for (int a = 0; a < 2; ++a)
#pragma unroll
            for (int b = 0; b < 2; ++b)
#pragma unroll
                for (int m = 0; m < 4; ++m)
#pragma unroll
                    for (int n = 0; n < 2; ++n) acc[a][b][m][n] = (f32x4){0.f, 0.f, 0.f, 0.f};
        cur = nxt; cA = nA; cB = nB; ++ui;
        if constexpr (ALIGN_EPI) { if (wr == 1) PG8_BAR; }
    }
    PG8_WAIT_V(0);
    if constexpr (!ALIGN_EPI) { if (wr == 0) PG8_BAR; }
    PG8_BAR;
#undef PG8_SA
#undef PG8_SB
#undef PG8_STAGE
#undef PG8_LDA
#undef PG8_LDB
#undef PG8_MMA
#undef PG8_WAIT_V
#undef PG8_WAIT_L
#undef PG8_BAR
#undef PG8_SCHED
}
}
using pg8::Unit;

struct NoRaw {};
struct RstdRaw { f32x4 a, b; };
__device__ __forceinline__ void rstd_issue(const float* ssq, int pm, RstdRaw& r) {
    const float* sp = ssq + ((size_t)pm * 256 + (threadIdx.x >> 1)) * 16 + (threadIdx.x & 1) * 8;
    r.a = *(const f32x4*)sp; r.b = *(const f32x4*)(sp + 4);
}
__device__ __forceinline__ void rstd_finish(const RstdRaw& r, LAS float* dst) {
    float t = ((r.a.x + r.a.y) + (r.a.z + r.a.w)) + ((r.b.x + r.b.y) + (r.b.z + r.b.w));
    t += __shfl_xor(t, 1);
    if ((threadIdx.x & 1) == 0) dst[threadIdx.x >> 1] = rsqrtf(t * (1.f / 1024.f) + EPS);
}
__device__ __forceinline__ void unit_rstd(const float* ssq, int row0, int fq, float (&rs)[2][4]) {
    f32x4 q[2][4];
#pragma unroll
    for (int ai = 0; ai < 2; ++ai)
#pragma unroll
        for (int m = 0; m < 4; ++m) q[ai][m] = *(const f32x4*)(ssq + (size_t)(row0 + ai * 128 + m * 16) * 16 + 4 * fq);
#pragma unroll
    for (int ai = 0; ai < 2; ++ai)
#pragma unroll
        for (int m = 0; m < 4; ++m) { float t = (q[ai][m].x + q[ai][m].y) + (q[ai][m].z + q[ai][m].w); t += __shfl_xor(t, 16); t += __shfl_xor(t, 32); rs[ai][m] = rsqrtf(t * (1.f / 1024.f) + EPS); }
}
__device__ __forceinline__ float row_rstd(const float* ssq, int row) {
    const f32x4* p = (const f32x4*)(ssq + (size_t)row * 16);
    const f32x4 a = p[0], b = p[1], c = p[2], d = p[3];
    const float s = ((a.x + a.y) + (a.z + a.w)) + ((b.x + b.y) + (b.z + b.w)) + ((c.x + c.y) + (c.z + c.w)) + ((d.x + d.y) + (d.z + d.w));
    return rsqrtf(s * (1.f / 1024.f) + EPS);
}
struct EpiFfnIn {
    static constexpr bool PERM = true;
    bf16_t* H; const float* ssq;
    typedef RstdRaw Raw;
    __device__ __forceinline__ void pre_issue(const Unit& u, int wr, int fr, int fq, Raw& r) const { rstd_issue(ssq, u.pm, r); }
    __device__ __forceinline__ void pre_finish(const Raw& r, LAS float* dst, int wr, int wc, int fr, int fq) const { rstd_finish(r, dst); }
    __device__ __forceinline__ void operator()(const f32x4 (&acc)[2][2][4][2], const Unit& u, int wr, int wc, int fr, int fq, const LAS float* rl) const {
        const int row0 = u.pm * 256 + wr * 64 + fr, col0 = u.pn * 128 + wc * 32 + 8 * fq;
        float rsa[2][4];
#pragma unroll
        for (int ai = 0; ai < 2; ++ai)
#pragma unroll
            for (int m = 0; m < 4; ++m) rsa[ai][m] = rl[ai * 128 + wr * 64 + m * 16 + fr];
#pragma unroll
        for (int ai = 0; ai < 2; ++ai)
#pragma unroll
            for (int m = 0; m < 4; ++m) {
                const int row = row0 + ai * 128 + m * 16; const float rs = rsa[ai][m];
                const float cexp = -1.4426950408889634f * rs, rs2 = rs * rs;
                f32x2 A2[4], B2[4], E2[4], H2[4];
#pragma unroll
                for (int n = 0; n < 2; ++n) { const f32x4 a = acc[ai][0][m][n], b = acc[ai][1][m][n];
                    A2[2 * n] = (f32x2){a.x, a.y}; A2[2 * n + 1] = (f32x2){a.z, a.w}; B2[2 * n] = (f32x2){b.x, b.y}; B2[2 * n + 1] = (f32x2){b.z, b.w}; }
#pragma unroll
                for (int q = 0; q < 4; ++q) { const f32x2 t = A2[q] * cexp; E2[q].x = __builtin_amdgcn_exp2f(t.x); E2[q].y = __builtin_amdgcn_exp2f(t.y); }
#pragma unroll
                for (int q = 0; q < 4; ++q) { const f32x2 d = E2[q] + 1.0f; E2[q].x = __builtin_amdgcn_rcpf(d.x); E2[q].y = __builtin_amdgcn_rcpf(d.y); }
#pragma unroll
                for (int q = 0; q < 4; ++q) H2[q] = (A2[q] * B2[q]) * rs2 * E2[q];
                u32x4 w; w.x = cvt_pk_bf16(H2[0].x, H2[0].y); w.y = cvt_pk_bf16(H2[1].x, H2[1].y); w.z = cvt_pk_bf16(H2[2].x, H2[2].y); w.w = cvt_pk_bf16(H2[3].x, H2[3].y);
                st16_wt(H + (size_t)row * DFF + col0, w);
            }
    }
};
template <bool FIRST>
struct EpiResid {
    static constexpr bool PERM = true;
    const float* xin_p; bf16_t* XB; float* ssq; float scale;
    typedef NoRaw Raw;
    __device__ __forceinline__ void pre_issue(const Unit&, int, int, int, Raw&) const {}
    __device__ __forceinline__ void pre_finish(const Raw&, LAS float*, int, int, int, int) const {}
    __device__ __forceinline__ void operator()(const f32x4 (&acc)[2][2][4][2], const Unit& u, int wr, int wc, int fr, int fq, const LAS float*) const {
        const int row0 = u.pm * 256 + wr * 64 + fr, col0 = u.pn * 256 + wc * 32 + 8 * fq;
#pragma unroll
        for (int ai = 0; ai < 2; ++ai) {
            f32x4 r[4][2][2];
#pragma unroll
            for (int m = 0; m < 4; ++m)
#pragma unroll
                for (int bj = 0; bj < 2; ++bj) {
                    const size_t off = (size_t)(row0 + ai * 128 + m * 16) * D + col0 + bj * 128;
                    if (FIRST) { r[m][bj][0] = *(const f32x4*)(xin_p + off); r[m][bj][1] = *(const f32x4*)(xin_p + off + 4); }
                    else { const u32x4 w = *(const u32x4*)(XB + off);
                        r[m][bj][0] = (f32x4){bf_lo(w.x), bf_hi(w.x), bf_lo(w.y), bf_hi(w.y)}; r[m][bj][1] = (f32x4){bf_lo(w.z), bf_hi(w.z), bf_lo(w.w), bf_hi(w.w)}; }
                }
            asm volatile("" ::: "memory");
#pragma unroll
            for (int m = 0; m < 4; ++m) {
                const int row = row0 + ai * 128 + m * 16;
                float sq = 0.f;
#pragma unroll
                for (int bj = 0; bj < 2; ++bj) {
                    const f32x4 o0 = r[m][bj][0] + acc[ai][bj][m][0] * scale, o1 = r[m][bj][1] + acc[ai][bj][m][1] * scale;
                    sq += ((o0.x * o0.x + o0.y * o0.y) + (o0.z * o0.z + o0.w * o0.w)) + ((o1.x * o1.x + o1.y * o1.y) + (o1.z * o1.z + o1.w * o1.w));
                    u32x4 w; w.x = cvt_pk_bf16(o0.x, o0.y); w.y = cvt_pk_bf16(o0.z, o0.w); w.z = cvt_pk_bf16(o1.x, o1.y); w.w = cvt_pk_bf16(o1.z, o1.w);
                    *(u32x4*)(XB + (size_t)row * D + col0 + bj * 128) = w;
                }
                sq += __shfl_xor(sq, 16); sq += __shfl_xor(sq, 32);
                if (fq == 0) ssq[(size_t)row * 16 + u.pn * 4 + wc] = sq;
            }
            asm volatile("" ::: "memory");
        }
    }
};
struct EpiEvIn {
    static constexpr bool PERM = true;
    bf16_t* P; float* Z; const float* ssq;
    typedef RstdRaw Raw;
    __device__ __forceinline__ void pre_issue(const Unit& u, int wr, int fr, int fq, Raw& r) const { rstd_issue(ssq, u.pm, r); }
    __device__ __forceinline__ void pre_finish(const Raw& r, LAS float* dst, int wr, int wc, int fr, int fq) const { rstd_finish(r, dst); }
    __device__ __forceinline__ void operator()(const f32x4 (&acc)[2][2][4][2], const Unit& u, int wr, int wc, int fr, int fq, const LAS float* rl) const {
        const int row0 = u.pm * 256 + wr * 64 + fr, col0 = u.pn * 256 + wc * 32 + 8 * fq;
        const int pn = u.pn;
        float rsa[2][4];
#pragma unroll
        for (int ai = 0; ai < 2; ++ai)
#pragma unroll
            for (int m = 0; m < 4; ++m) rsa[ai][m] = rl[ai * 128 + wr * 64 + m * 16 + fr];
#pragma unroll
        for (int ai = 0; ai < 2; ++ai)
#pragma unroll
            for (int m = 0; m < 4; ++m) {
                const int row = row0 + ai * 128 + m * 16; const float rs = rsa[ai][m];
                if (pn == 10) {
                    if (wc == 0 && fq < 2) {
                        *(f32x4*)(Z + (size_t)row * 16 + 8 * fq) = acc[ai][0][m][0] * rs;
                        *(f32x4*)(Z + (size_t)row * 16 + 8 * fq + 4) = acc[ai][0][m][1] * rs;
                    }
                } else {
#pragma unroll
                    for (int bj = 0; bj < 2; ++bj) {
                        f32x2 X2[4];
#pragma unroll
                        for (int n = 0; n < 2; ++n) { const f32x4 a = acc[ai][bj][m][n] * rs; X2[2 * n] = (f32x2){a.x, a.y}; X2[2 * n + 1] = (f32x2){a.z, a.w}; }
                        if (pn == 0) {
#pragma unroll
                            for (int q = 0; q < 4; ++q) X2[q] = X2[q] * 0.125f;
                        } else if (pn >= 4) {
                            f32x2 E2[4];
#pragma unroll
                            for (int q = 0; q < 4; ++q) { f32x2 t = X2[q];
                                if (pn >= 6) t = t * ((t * t) * (0.044715f * 1.5957691216057308f) + 1.5957691216057308f);
                                t = t * (-1.4426950408889634f);
                                E2[q].x = __builtin_amdgcn_exp2f(t.x); E2[q].y = __builtin_amdgcn_exp2f(t.y); }
#pragma unroll
                            for (int q = 0; q < 4; ++q) { const f32x2 d = E2[q] + 1.0f; E2[q].x = __builtin_amdgcn_rcpf(d.x); E2[q].y = __builtin_amdgcn_rcpf(d.y); }
#pragma unroll
                            for (int q = 0; q < 4; ++q) X2[q] = X2[q] * E2[q];
                        }
                        u32x4 w; w.x = cvt_pk_bf16(X2[0].x, X2[0].y); w.y = cvt_pk_bf16(X2[1].x, X2[1].y); w.z = cvt_pk_bf16(X2[2].x, X2[2].y); w.w = cvt_pk_bf16(X2[3].x, X2[3].y);
                        st16_wt(P + (size_t)row * PEV_LD + col0 + bj * 128, w);
                    }
                }
            }
    }
};
struct EpiOdIn {
    static constexpr bool PERM = true;
    bf16_t* P; float* out; const float* ssq;
    typedef RstdRaw Raw;
    __device__ __forceinline__ void pre_issue(const Unit& u, int wr, int fr, int fq, Raw& r) const { rstd_issue(ssq, u.pm, r); }
    __device__ __forceinline__ void pre_finish(const Raw& r, LAS float* dst, int wr, int wc, int fr, int fq) const { rstd_finish(r, dst); }
    __device__ __forceinline__ void operator()(const f32x4 (&acc)[2][2][4][2], const Unit& u, int wr, int wc, int fr, int fq, const LAS float* rl) const {
        const int row0 = u.pm * 256 + wr * 64 + fr;
        const int pn = u.pn;
        float rsa[2][4];
#pragma unroll
        for (int ai = 0; ai < 2; ++ai)
#pragma unroll
            for (int m = 0; m < 4; ++m) rsa[ai][m] = rl[ai * 128 + wr * 64 + m * 16 + fr];
#pragma unroll
        for (int ai = 0; ai < 2; ++ai)
#pragma unroll
            for (int m = 0; m < 4; ++m) {
                const int row = row0 + ai * 128 + m * 16; const float rs = rsa[ai][m];
                const int t = row & 2047, b = row >> 11;
                if (pn < 4) {
                    const int col = pn * 128 + wc * 32 + 8 * fq;
                    float v[8];
                    {
                        const float cexp = -1.4426950408889634f * rs;
                        f32x2 E2[4], V2[4];
#pragma unroll
                        for (int n = 0; n < 2; ++n) { const f32x4 g = acc[ai][1][m][n] * cexp;
                            E2[2 * n].x = __builtin_amdgcn_exp2f(g.x); E2[2 * n].y = __builtin_amdgcn_exp2f(g.y); E2[2 * n + 1].x = __builtin_amdgcn_exp2f(g.z); E2[2 * n + 1].y = __builtin_amdgcn_exp2f(g.w); }
#pragma unroll
                        for (int q = 0; q < 4; ++q) { const f32x2 d = E2[q] + 1.0f; E2[q].x = __builtin_amdgcn_rcpf(d.x); E2[q].y = __builtin_amdgcn_rcpf(d.y); }
#pragma unroll
                        for (int n = 0; n < 2; ++n) { const f32x4 a = acc[ai][0][m][n] * rs; V2[2 * n] = (f32x2){a.x, a.y} * E2[2 * n]; V2[2 * n + 1] = (f32x2){a.z, a.w} * E2[2 * n + 1]; }
#pragma unroll
                        for (int q = 0; q < 4; ++q) { v[2 * q] = V2[q].x; v[2 * q + 1] = V2[q].y; }
                    }
                    u32x4 w; w.x = cvt_pk_bf16(v[0], v[1]); w.y = cvt_pk_bf16(v[2], v[3]); w.z = cvt_pk_bf16(v[4], v[5]); w.w = cvt_pk_bf16(v[6], v[7]);
                    *(u32x4*)(P + (size_t)row * POD_LD + col) = w;
                    float* o = nullptr;
                    if (row < MP) { if (t >= SEQ - 30) o = out + O_CONVP + ((size_t)(b * 30 + t - (SEQ - 30))) * 512 + col; }
                    else if (row < MT) o = out + O_CONVS + ((size_t)((row - MP) * 30 + 29)) * 512 + col;
                    if (o) { *(f32x4*)o = (f32x4){v[0], v[1], v[2], v[3]}; *(f32x4*)(o + 4) = (f32x4){v[4], v[5], v[6], v[7]}; }
                } else {
#pragma unroll
                    for (int bj = 0; bj < 2; ++bj) {
                        const int col = (pn - 4) * 256 + bj * 128 + wc * 32 + 8 * fq;
                        const f32x4 v0 = acc[ai][bj][m][0] * rs, v1 = acc[ai][bj][m][1] * rs;
                        u32x4 w; w.x = cvt_pk_bf16(v0.x, v0.y); w.y = cvt_pk_bf16(v0.z, v0.w); w.z = cvt_pk_bf16(v1.x, v1.y); w.w = cvt_pk_bf16(v1.z, v1.w);
                        *(u32x4*)(P + (size_t)row * POD_LD + 512 + col) = w;
                        float* o = nullptr;
                        if (row < MP) { if (t >= SEQ - 15) o = out + O_POOLP + ((size_t)(b * 15 + t - (SEQ - 15))) * 512 + col; }
                        else if (row < MT) o = out + O_POOLS + ((size_t)((row - MP) * 15 + 14)) * 512 + col;
                        if (o) { *(f32x4*)o = v0; *(f32x4*)(o + 4) = v1; }
                    }
                }
            }
    }
};
struct EpiPool {
    static constexpr bool PERM = true;
    bf16_t* MIX; const float* scale;
    __device__ __forceinline__ void operator()(const f32x4 (&acc)[2][2][4][2], const Unit& u, int wr, int wc, int fr, int fq) const {
        const int row0 = u.pm * 256 + wr * 64 + fr, col0 = u.pn * 256 + wc * 32 + 8 * fq;
#pragma unroll
        for (int bj = 0; bj < 2; ++bj) {
            const int col = col0 + bj * 128;
            const f32x4 s0 = *(const f32x4*)(scale + col), s1 = *(const f32x4*)(scale + col + 4);
#pragma unroll
            for (int ai = 0; ai < 2; ++ai)
#pragma unroll
                for (int m = 0; m < 4; ++m) {
                    const int row = row0 + ai * 128 + m * 16;
                    const f32x4 v0 = acc[ai][bj][m][0] * s0, v1 = acc[ai][bj][m][1] * s1;
                    u32x4 w; w.x = cvt_pk_bf16(v0.x, v0.y); w.y = cvt_pk_bf16(v0.z, v0.w); w.z = cvt_pk_bf16(v1.x, v1.y); w.w = cvt_pk_bf16(v1.z, v1.w);
                    *(u32x4*)(MIX + (size_t)row * D + 512 + col) = w;
                }
        }
    }
};

__device__ __forceinline__ int colmap(int mode, int n) {
    if (mode == 0) return n;
    if (mode == 1) { const int pn = n >> 8, j = n & 255; return j < 128 ? 128 * pn + j : 2816 + 128 * pn + (j - 128); }
    if (mode == 2) { return n < 1536 ? n : (n < 2560 ? n + 16 : (n < 2576 ? n - 1024 : -1)); }
    if (n < 1024) { const int pn = n >> 8, j = n & 255; return j < 128 ? 128 * pn + j : 512 + 128 * pn + (j - 128); }
    return n;
}
__device__ __forceinline__ void tr_item(const float* W, int ldw, int srccol4, const float* gain, bf16_t* dst, int K, LAS float* scr, int lane) {
    const int kl = lane >> 4, n4 = (lane & 15) * 4;
    f32x4 v[16];
#pragma unroll
    for (int i = 0; i < 16; ++i) { const int kk = 4 * i + kl; v[i] = (srccol4 >= 0) ? *(const f32x4*)(W + (size_t)kk * ldw + srccol4) : (f32x4){0.f, 0.f, 0.f, 0.f}; }
#pragma unroll
    for (int i = 0; i < 16; ++i) { const int kk = 4 * i + kl; f32x4 x = v[i]; if (gain) x *= gain[kk];
        LAS float* d = scr + kk * 65 + n4; d[0] = x.x; d[1] = x.y; d[2] = x.z; d[3] = x.w; }
    LDS_WAIT();
    const int c = lane & 7;
#pragma unroll
    for (int j = 0; j < 8; ++j) { const int n = (lane >> 3) + 8 * j; const LAS float* s = scr + (8 * c) * 65 + n;
        u32x4 o; o.x = cvt_pk_bf16(s[0 * 65], s[1 * 65]); o.y = cvt_pk_bf16(s[2 * 65], s[3 * 65]); o.z = cvt_pk_bf16(s[4 * 65], s[5 * 65]); o.w = cvt_pk_bf16(s[6 * 65], s[7 * 65]);
        st16_wt(dst + (size_t)(n) * K + 8 * c, o); }
    LDS_WAIT();
}
__device__ __forceinline__ void prep_one(const Params& p, int it, LAS float* scr, int lane) {
    const float* norm_g = p.in[5];
    const float* W; int K, Np, ldw, mode; const float* gain = nullptr; bf16_t* Bt; int r = it;
    if (r < 5632) { const int idx = r / 1408; r -= idx * 1408; const int l = idx >> 1, j = idx & 1;
        W = p.in[6] + (size_t)idx * 1024 * 5632; K = 1024; Np = 5632; ldw = 5632; mode = 1; gain = norm_g + (l * 3 + (j ? 2 : 0)) * 1024; Bt = (bf16_t*)(p.ws + WS_WFFIN) + (size_t)idx * 5632 * 1024; }
    else if (r < 8448) { r -= 5632; const int idx = r / 704; r -= idx * 704;
        W = p.in[7] + (size_t)idx * 2816 * 1024; K = 2816; Np = 1024; ldw = 1024; mode = 0; Bt = (bf16_t*)(p.ws + WS_WFFOUT) + (size_t)idx * 1024 * 2816; }
    else if (r < 9152) { r -= 8448; W = p.in[8]; K = 1024; Np = 2816; ldw = 2576; mode = 2; gain = norm_g + 1 * 1024; Bt = (bf16_t*)(p.ws + WS_WEVIN); }
    else if (r < 9408) { r -= 9152; W = p.in[16]; K = 1024; Np = 1024; ldw = 1024; mode = 0; Bt = (bf16_t*)(p.ws + WS_WEVOUT); }
    else if (r < 9792) { r -= 9408; W = p.in[17]; K = 1024; Np = 1536; ldw = 1536; mode = 3; gain = norm_g + 4 * 1024; Bt = (bf16_t*)(p.ws + WS_WODIN); }
    else if (r < 10048) { r -= 9792; W = p.in[24]; K = 1024; Np = 1024; ldw = 1024; mode = 0; Bt = (bf16_t*)(p.ws + WS_WODOUT); }
    else { r -= 10048; W = p.in[22]; K = 512; Np = 512; ldw = 128; mode = 4; Bt = (bf16_t*)(p.ws + WS_WPOOL); }
    const int nblk = Np / 64, kb = r / nblk, nb = r % nblk, k0 = 64 * kb, n0 = 64 * nb;
    int sc; const float* Wp;
    if (mode == 4) { const int gk = k0 >> 7, gn = n0 >> 7; sc = (gk == gn) ? (n0 & 127) + (lane & 15) * 4 : -1; Wp = W + (size_t)gk * 16384 + (size_t)(k0 & 127) * 128; }
    else { sc = colmap(mode, n0 + (lane & 15) * 4); Wp = W + (size_t)k0 * ldw; }
    tr_item(Wp, ldw, sc, gain ? gain + k0 : nullptr, Bt + (size_t)n0 * K + k0, K, scr, lane);
}
__device__ __forceinline__ void prep_range(const Params& p, LAS unsigned char* L, int lo, int hi, int wi, int nw) {
    const int lane = threadIdx.x & 63, wave = threadIdx.x >> 6;
    LAS float* scr = (LAS float*)(L + wave * 16640);
    for (int it = lo + wi; it < hi; it += nw) prep_one(p, it, scr, lane);
}
__device__ __forceinline__ void tail_prep(const Params& p, LAS unsigned char* L, int nwg, int lo1, int hi1, int lo2, int hi2) {
    const int G = gridDim.x, rem = nwg % G, bx = blockIdx.x, wave = threadIdx.x >> 6;
    int wi, nw;
    if (rem == 0) { wi = bx * 8 + wave; nw = G * 8; } else { if (bx < rem) return; wi = (bx - rem) * 8 + wave; nw = (G - rem) * 8; }
    prep_range(p, L, lo1, hi1, wi, nw);
    prep_range(p, L, lo2, hi2, wi, nw);
}
__device__ __forceinline__ void phase_prep(const Params& p, LAS unsigned char* L) {
    const int tid = threadIdx.x, lane = tid & 63, wave = tid >> 6;
    const int gw = blockIdx.x * 8 + wave, NGW = gridDim.x * 8;
    prep_range(p, L, 0, 1408, gw, NGW);
    bf16_t* XB = (bf16_t*)(p.ws + WS_XB); float* ssq = (float*)(p.ws + WS_SSQ);
    for (int row = gw; row < MPAD; row += NGW) {
        float s = 0.f;
        if (row < MT) {
            const float* src = row < MP ? p.in[0] + (size_t)row * D : p.in[1] + (size_t)(row - MP) * D;
            f32x4 xv[4];
#pragma unroll
            for (int j = 0; j < 2; ++j) { xv[2 * j] = *(const f32x4*)(src + 8 * lane + 512 * j); xv[2 * j + 1] = *(const f32x4*)(src + 8 * lane + 512 * j + 4); }
#pragma unroll
            for (int j = 0; j < 2; ++j) { const f32x4 a = xv[2 * j], c = xv[2 * j + 1];
                s += ((a.x * a.x + a.y * a.y) + (a.z * a.z + a.w * a.w)) + ((c.x * c.x + c.y * c.y) + (c.z * c.z + c.w * c.w));
                u32x4 w; w.x = cvt_pk_bf16(a.x, a.y); w.y = cvt_pk_bf16(a.z, a.w); w.z = cvt_pk_bf16(c.x, c.y); w.w = cvt_pk_bf16(c.z, c.w);
                st16_wt(XB + (size_t)row * D + 8 * lane + 512 * j, w); }
            s = wave_sum(s);
        } else {
#pragma unroll
            for (int j = 0; j < 2; ++j) st16_wt(XB + (size_t)row * D + 8 * lane + 512 * j, (u32x4){0u, 0u, 0u, 0u});
        }
        if (lane < 16) ssq[(size_t)row * 16 + lane] = (lane == 0) ? s : 0.f;
    }
}

__device__ __forceinline__ void gla_cum(const Params& p, int h, int t0, LAS float* cum, LAS float* zs, LAS float* wgs, LAS float* bgs, LAS float* seg) {
    const int tid = threadIdx.x;
    const float* zb = (const float*)(p.ws + WS_Z);
    for (int i = tid; i < 1024; i += 512) zs[i] = zb[(size_t)t0 * 16 + i];
    for (int i = tid; i < 1024; i += 512) { const int r = i >> 6, k = i & 63; wgs[i] = p.in[9][r * 256 + h * 64 + k]; }
    if (tid < 64) bgs[tid] = p.in[10][h * 64 + tid];
    __syncthreads();
    const int kk = tid & 63, sg = tid >> 6;
    float wv[16];
#pragma unroll
    for (int r = 0; r < 16; ++r) wv[r] = wgs[r * 64 + kk];
    const float bb = bgs[kk];
    float run = 0.f, loc[8];
#pragma unroll
    for (int i = 0; i < 8; ++i) { const int s = sg * 8 + i; float g = bb;
#pragma unroll
        for (int r = 0; r < 16; ++r) g += zs[s * 16 + r] * wv[r];
        const float la = (fminf(g, 0.f) - __logf(1.f + __expf(-fabsf(g)))) * (1.f / 16.f);
        run += la; loc[i] = run; }
    seg[sg * 64 + kk] = run;
    __syncthreads();
    float off = 0.f;
#pragma unroll
    for (int j = 0; j < 8; ++j) if (j < sg) off += seg[j * 64 + kk];
#pragma unroll
    for (int i = 0; i < 8; ++i) cum[(sg * 8 + i) * 65 + kk] = off + loc[i];
    __syncthreads();
}
__device__ __forceinline__ f32x4 mma16(const LAS bf16_t* A, int pa, const LAS bf16_t* B, int pb, int ksteps, f32x4 acc, int fr, int fq) {
#pragma unroll
    for (int ks = 0; ks < ksteps; ++ks) {
        const bf16x8 a = *(const LAS bf16x8*)(A + fr * pa + ks * 32 + fq * 8);
        const bf16x8 b = *(const LAS bf16x8*)(B + fr * pb + ks * 32 + fq * 8);
        acc = __builtin_amdgcn_mfma_f32_16x16x32_bf16(a, b, acc, 0, 0, 0);
    }
    return acc;
}
constexpr int PT = 72;
__device__ __forceinline__ void stage_vt(const bf16_t* pev, int t0, int h, LAS bf16_t* Vt) {
    for (int i = threadIdx.x; i < 1024; i += 512) { const int sI = i >> 4, c8 = (i & 15) * 8;
        const u32x4 w = *(const u32x4*)(pev + (size_t)(t0 + sI) * PEV_LD + 512 + h * 128 + c8);
        const unsigned ww[4] = {w.x, w.y, w.z, w.w};
#pragma unroll
        for (int j = 0; j < 4; ++j) { Vt[(c8 + 2 * j) * PT + sI] = (bf16_t)(ww[j] & 0xffffu); Vt[(c8 + 2 * j + 1) * PT + sI] = (bf16_t)(ww[j] >> 16); } }
}
__device__ __forceinline__ void gla_a_item(const Params& p, LAS unsigned char* L, int item) {
    const int tid = threadIdx.x, wave = tid >> 6, lane = tid & 63, fr = lane & 15, fq = lane >> 4;
    const int b = item >> 7, h = (item >> 5) & 3, c = item & 31, t0 = b * SEQ + c * 64;
    LAS float* cum = (LAS float*)L; LAS bf16_t* Kt = (LAS bf16_t*)(cum + 4160); LAS bf16_t* Vt = Kt + 64 * PT;
    LAS float* zs = (LAS float*)(Vt + 128 * PT); LAS float* wgs = zs + 1024; LAS float* bgs = wgs + 1024; LAS float* seg = bgs + 64;
    gla_cum(p, h, t0, cum, zs, wgs, bgs, seg);
    const bf16_t* pev = (const bf16_t*)(p.ws + WS_H);
    {
        const int kk = tid & 63, sg = tid >> 6;
        const float last = cum[63 * 65 + kk];
        float* cb = (float*)(p.ws + WS_X) + (size_t)item * 4096;
        float kv[8];
#pragma unroll
        for (int i = 0; i < 8; ++i) { const int sI = sg * 8 + i; const float cm = cum[sI * 65 + kk]; cb[sI * 64 + kk] = cm;
            kv[i] = bf1(pev[(size_t)(t0 + sI) * PEV_LD + 256 + h * 64 + kk]) * __expf(last - cm); }
        u32x4 w; w.x = cvt_pk_bf16(kv[0], kv[1]); w.y = cvt_pk_bf16(kv[2], kv[3]); w.z = cvt_pk_bf16(kv[4], kv[5]); w.w = cvt_pk_bf16(kv[6], kv[7]);
        *(LAS u32x4*)(Kt + kk * PT + sg * 8) = w;
        if (tid < 64) ((float*)(p.ws + WS_DEC))[(size_t)item * 64 + tid] = __expf(last);
    }
    stage_vt(pev, t0, h, Vt);
    __syncthreads();
    float* KV = (float*)(p.ws + WS_KV) + (size_t)item * 8192;
#pragma unroll
    for (int kt = 0; kt < 4; ++kt) {
        const f32x4 acc = mma16(Kt + kt * 16 * PT, PT, Vt + wave * 16 * PT, PT, 2, (f32x4){0.f, 0.f, 0.f, 0.f}, fr, fq);
#pragma unroll
        for (int j = 0; j < 4; ++j) KV[(kt * 16 + fq * 4 + j) * 128 + wave * 16 + fr] = acc[j];
    }
    __syncthreads();
}
__device__ __forceinline__ void gla_scan_item(const Params& p, int item) {
    const int bh = item >> 4, e = (item & 15) * 512 + threadIdx.x, k = e >> 7;
    float* KV = (float*)(p.ws + WS_KV); const float* dec = (const float*)(p.ws + WS_DEC);
    float S = 0.f, kvv[32], dd[32];
#pragma unroll
    for (int c = 0; c < 32; ++c) { const size_t it = (size_t)bh * 32 + c; kvv[c] = KV[it * 8192 + e]; dd[c] = dec[it * 64 + k]; }
    bf16_t* Sb = (bf16_t*)(p.ws + WS_X + (16u << 20));
#pragma unroll
    for (int c = 0; c < 32; ++c) { const size_t it = (size_t)bh * 32 + c; Sb[it * 8192 + e] = (bf16_t)(cvt_pk_bf16(S, 0.f) & 0xffffu); S = dd[c] * S + kvv[c]; }
    p.out[O_GLAP + (size_t)bh * 8192 + e] = S;
}
__device__ __forceinline__ void gla_c_item(const Params& p, LAS unsigned char* L, int item) {
    const int tid = threadIdx.x, wave = tid >> 6, lane = tid & 63, fr = lane & 15, fq = lane >> 4;
    const int b = item >> 7, h = (item >> 5) & 3, c = item & 31, t0 = b * SEQ + c * 64;
    LAS bf16_t* Qs = (LAS bf16_t*)L; LAS bf16_t* Ks = Qs + 64 * PT; LAS bf16_t* Ps = Ks + 64 * PT; LAS bf16_t* Vt = Ps + 64 * PT; LAS bf16_t* St = Vt + 128 * PT;
    LAS float* Os = (LAS float*)Vt;
    const bf16_t* pev = (const bf16_t*)(p.ws + WS_H);
    const int vq8 = tid & 15, tq2 = tid >> 4;
    u32x4 rwv[2];
#pragma unroll
    for (int i = 0; i < 2; ++i) rwv[i] = *(const u32x4*)(pev + (size_t)(t0 + 2 * tq2 + i) * PEV_LD + 1024 + h * 128 + 8 * vq8);
    {
        const int sI = tid & 63, kg = tid >> 6;
        const u32x4 qw = *(const u32x4*)(pev + (size_t)(t0 + sI) * PEV_LD + h * 64 + kg * 8);
        const u32x4 kw = *(const u32x4*)(pev + (size_t)(t0 + sI) * PEV_LD + 256 + h * 64 + kg * 8);
        const float* cb = (const float*)(p.ws + WS_X) + (size_t)item * 4096 + sI * 64 + kg * 8;
        const f32x4 c0 = *(const f32x4*)cb, c1 = *(const f32x4*)(cb + 4);
        const float cm[8] = {c0.x, c0.y, c0.z, c0.w, c1.x, c1.y, c1.z, c1.w};
        const float qv[8] = {bf_lo(qw.x), bf_hi(qw.x), bf_lo(qw.y), bf_hi(qw.y), bf_lo(qw.z), bf_hi(qw.z), bf_lo(qw.w), bf_hi(qw.w)};
        const float kv[8] = {bf_lo(kw.x), bf_hi(kw.x), bf_lo(kw.y), bf_hi(kw.y), bf_lo(kw.z), bf_hi(kw.z), bf_lo(kw.w), bf_hi(kw.w)};
        float qe[8], ke[8];
#pragma unroll
        for (int i = 0; i < 8; ++i) { qe[i] = qv[i] * __expf(cm[i]); ke[i] = kv[i] * __expf(-cm[i]); }
        u32x4 w; w.x = cvt_pk_bf16(qe[0], qe[1]); w.y = cvt_pk_bf16(qe[2], qe[3]); w.z = cvt_pk_bf16(qe[4], qe[5]); w.w = cvt_pk_bf16(qe[6], qe[7]);
        *(LAS u32x4*)(Qs + sI * PT + kg * 8) = w;
        w.x = cvt_pk_bf16(ke[0], ke[1]); w.y = cvt_pk_bf16(ke[2], ke[3]); w.z = cvt_pk_bf16(ke[4], ke[5]); w.w = cvt_pk_bf16(ke[6], ke[7]);
        *(LAS u32x4*)(Ks + sI * PT + kg * 8) = w;
    }
    stage_vt(pev, t0, h, Vt);
    {
        const bf16_t* Sb = (const bf16_t*)(p.ws + WS_X + (16u << 20)) + (size_t)item * 8192;
        for (int i = tid; i < 1024; i += 512) { const int k = i >> 4, v8 = (i & 15) * 8; const u32x4 x = *(const u32x4*)(Sb + k * 128 + v8);
            const unsigned ww[4] = {x.x, x.y, x.z, x.w};
#pragma unroll
            for (int j = 0; j < 4; ++j) { St[(v8 + 2 * j) * PT + k] = (bf16_t)(ww[j] & 0xffffu); St[(v8 + 2 * j + 1) * PT + k] = (bf16_t)(ww[j] >> 16); } }
    }
    __syncthreads();
    {
        const int tt = wave >> 1;
#pragma unroll
        for (int si = 0; si < 2; ++si) { const int st = (wave & 1) * 2 + si;
            const f32x4 acc = mma16(Qs + tt * 16 * PT, PT, Ks + st * 16 * PT, PT, 2, (f32x4){0.f, 0.f, 0.f, 0.f}, fr, fq);
#pragma unroll
            for (int j = 0; j < 4; ++j) { const int t = tt * 16 + fq * 4 + j, sI = st * 16 + fr; const float v = (sI <= t) ? acc[j] : 0.f;
                Ps[t * PT + sI] = (bf16_t)(cvt_pk_bf16(v, 0.f) & 0xffffu); } }
    }
    __syncthreads();
    f32x4 oacc[4];
#pragma unroll
    for (int tt = 0; tt < 4; ++tt) {
        f32x4 a = mma16(Qs + tt * 16 * PT, PT, St + wave * 16 * PT, PT, 2, (f32x4){0.f, 0.f, 0.f, 0.f}, fr, fq);
        oacc[tt] = mma16(Ps + tt * 16 * PT, PT, Vt + wave * 16 * PT, PT, 2, a, fr, fq);
    }
    __syncthreads();
#pragma unroll
    for (int tt = 0; tt < 4; ++tt)
#pragma unroll
        for (int j = 0; j < 4; ++j) Os[(tt * 16 + fq * 4 + j) * 132 + wave * 16 + fr] = oacc[tt][j];
    __syncthreads();
    bf16_t* mix = (bf16_t*)(p.ws + WS_MIX);
    const f32x4 ga = *(const f32x4*)(p.in[11] + h * 128 + 8 * vq8), gb = *(const f32x4*)(p.in[11] + h * 128 + 8 * vq8 + 4);
#pragma unroll
    for (int i = 0; i < 2; ++i) {
        const int t = 2 * tq2 + i;
        const f32x4 a = *(const LAS f32x4*)(Os + t * 132 + 8 * vq8), c = *(const LAS f32x4*)(Os + t * 132 + 8 * vq8 + 4);
        float ss = ((a.x * a.x + a.y * a.y) + (a.z * a.z + a.w * a.w)) + ((c.x * c.x + c.y * c.y) + (c.z * c.z + c.w * c.w));
#pragma unroll
        for (int o = 1; o < 16; o <<= 1) ss += __shfl_xor(ss, o);
        const float rs = rsqrtf(ss * (1.f / 128.f) + EPS);
        const u32x4 rw = rwv[i];
        const f32x4 o0 = a * rs * ga * (f32x4){bf_lo(rw.x), bf_hi(rw.x), bf_lo(rw.y), bf_hi(rw.y)};
        const f32x4 o1 = c * rs * gb * (f32x4){bf_lo(rw.z), bf_hi(rw.z), bf_lo(rw.w), bf_hi(rw.w)};
        u32x4 w; w.x = cvt_pk_bf16(o0.x, o0.y); w.y = cvt_pk_bf16(o0.z, o0.w); w.z = cvt_pk_bf16(o1.x, o1.y); w.w = cvt_pk_bf16(o1.z, o1.w);
        st16_wt(mix + (size_t)(t0 + t) * D + h * 128 + 8 * vq8, w);
    }
    __syncthreads();
}
__device__ __forceinline__ void gla_s_item(const Params& p, LAS unsigned char* L, int item) {
    const int tid = threadIdx.x, seq = item >> 2, h = item & 3, row = MP + seq;
    LAS float* qs = (LAS float*)L; LAS float* ks = qs + 64; LAS float* ds = ks + 64; LAS float* po = ds + 64; LAS float* red = po + 512;
    const bf16_t* pev = (const bf16_t*)(p.ws + WS_H);
    if (tid < 64) {
        const float* z = (const float*)(p.ws + WS_Z) + (size_t)row * 16;
        float g = p.in[10][h * 64 + tid];
#pragma unroll
        for (int r = 0; r < 16; ++r) g += z[r] * p.in[9][r * 256 + h * 64 + tid];
        const float la = (fminf(g, 0.f) - log1pf(__expf(-fabsf(g)))) * (1.f / 16.f);
        ds[tid] = __expf(la);
        qs[tid] = bf1(pev[(size_t)row * PEV_LD + h * 64 + tid]);
        ks[tid] = bf1(pev[(size_t)row * PEV_LD + 256 + h * 64 + tid]);
    }
    __syncthreads();
    const int v = tid & 127, kq = tid >> 7;
    const float vv = bf1(pev[(size_t)row * PEV_LD + 512 + h * 128 + v]);
    const float* S0 = p.in[2] + (size_t)item * 8192; float* S1 = p.out + O_GLAS + (size_t)item * 8192;
    float o = 0.f;
    float s0v[16];
#pragma unroll
    for (int i = 0; i < 16; ++i) s0v[i] = S0[(kq * 16 + i) * 128 + v];
#pragma unroll
    for (int i = 0; i < 16; ++i) { const int k = kq * 16 + i; const float s0 = s0v[i]; const float d = ds[k]; o += qs[k] * d * s0; S1[k * 128 + v] = d * s0 + ks[k] * vv; }
    po[kq * 128 + v] = o;
    __syncthreads();
    float ot = 0.f;
    if (tid < 128) {
        float qk = 0.f;
#pragma unroll 8
        for (int k = 0; k < 64; ++k) qk += qs[k] * ks[k];
        ot = po[v] + po[128 + v] + po[256 + v] + po[384 + v] + qk * vv;
    }
    const float ss = wave_sum(ot * ot);
    if (tid < 128 && (tid & 63) == 0) red[tid >> 6] = ss;
    __syncthreads();
    if (tid < 128) {
        const float rs = rsqrtf((red[0] + red[1]) * (1.f / 128.f) + EPS);
        const float r = bf1(pev[(size_t)row * PEV_LD + 1024 + h * 128 + v]);
        const float ov = ot * rs * p.in[11][h * 128 + v] * r;
        ((bf16_t*)(p.ws + WS_MIX))[(size_t)row * D + h * 128 + v] = (bf16_t)(cvt_pk_bf16(ov, 0.f) & 0xffffu);
    }
    __syncthreads();
}

constexpr int PW = 136;
__device__ __forceinline__ void sg_item(const Params& p, LAS unsigned char* L, int item) {
    const int tid = threadIdx.x, wave = tid >> 6, lane = tid & 63, fr = lane & 15, fq = lane >> 4;
    const int h = item & 3, n = (item >> 2) & 15, b = item >> 6, t0 = b * SEQ + n * 128;
    LAS bf16_t* Wb = (LAS bf16_t*)L; LAS bf16_t* vT = Wb + 128 * PW; LAS float* mu = (LAS float*)(vT + 128 * PW); LAS float* rsd = mu + 128; LAS float* Os = rsd + 128;
    const bf16_t* pev = (const bf16_t*)(p.ws + WS_H);
    u32x4 vw[4], uwv[4]; float bv[4];
    {
        const int d8 = (tid & 15) * 8, sr = tid >> 4, tb = 4 * (tid >> 4);
#pragma unroll
        for (int ps = 0; ps < 4; ++ps) vw[ps] = *(const u32x4*)(pev + (size_t)(t0 + ps * 32 + sr) * PEV_LD + 2048 + h * 128 + d8);
#pragma unroll
        for (int i = 0; i < 4; ++i) { bv[i] = p.in[15][h * 128 + tb + i]; uwv[i] = *(const u32x4*)(pev + (size_t)(t0 + tb + i) * PEV_LD + 1536 + h * 128 + d8); }
    }
    {
        const int q = tid & 3, sI = tid >> 2;
        const bf16_t* src = pev + (size_t)(t0 + sI) * PEV_LD + 2048 + q * 128;
        float sm = 0.f, sq = 0.f;
#pragma unroll 4
        for (int i = 0; i < 16; ++i) { const u32x4 w = *(const u32x4*)(src + 8 * i);
            const float f[8] = {bf_lo(w.x), bf_hi(w.x), bf_lo(w.y), bf_hi(w.y), bf_lo(w.z), bf_hi(w.z), bf_lo(w.w), bf_hi(w.w)};
#pragma unroll
            for (int j = 0; j < 8; ++j) { sm += f[j]; sq += f[j] * f[j]; } }
        sm += __shfl_xor(sm, 1); sm += __shfl_xor(sm, 2); sq += __shfl_xor(sq, 1); sq += __shfl_xor(sq, 2);
        const float mean = sm * (1.f / 512.f), var = fmaxf(sq * (1.f / 512.f) - mean * mean, 0.f);
        if (q == 0) { mu[sI] = mean; rsd[sI] = rsqrtf(var + EPS); }
    }
    for (int i = tid; i < 2048; i += 512) {
        const int t = i >> 4, s8 = (i & 15) * 8;
        const float* wrow = p.in[14] + ((size_t)h * 128 + t) * 128 + s8;
        const f32x4 a = *(const f32x4*)wrow, c = *(const f32x4*)(wrow + 4);
        float f[8] = {a.x, a.y, a.z, a.w, c.x, c.y, c.z, c.w};
#pragma unroll
        for (int j = 0; j < 8; ++j) if (s8 + j > t) f[j] = 0.f;
        u32x4 w; w.x = cvt_pk_bf16(f[0], f[1]); w.y = cvt_pk_bf16(f[2], f[3]); w.z = cvt_pk_bf16(f[4], f[5]); w.w = cvt_pk_bf16(f[6], f[7]);
        *(LAS u32x4*)(Wb + t * PW + s8) = w;
    }
    __syncthreads();
    {
        const int d8 = (tid & 15) * 8, sr = tid >> 4;
        const f32x4 g0 = *(const f32x4*)(p.in[12] + h * 128 + d8), g1 = *(const f32x4*)(p.in[12] + h * 128 + d8 + 4);
        const f32x4 b0 = *(const f32x4*)(p.in[13] + h * 128 + d8), b1 = *(const f32x4*)(p.in[13] + h * 128 + d8 + 4);
#pragma unroll
        for (int ps = 0; ps < 4; ++ps) { const int sI = ps * 32 + sr;
            const u32x4 w = vw[ps];
            const float m = mu[sI], r = rsd[sI];
            const f32x4 x0 = ((f32x4){bf_lo(w.x), bf_hi(w.x), bf_lo(w.y), bf_hi(w.y)} - m) * r * g0 + b0;
            const f32x4 x1 = ((f32x4){bf_lo(w.z), bf_hi(w.z), bf_lo(w.w), bf_hi(w.w)} - m) * r * g1 + b1;
            if (n == 15) { float* o = p.out + O_SGVP + ((size_t)(b * 128 + sI)) * 512 + h * 128 + d8; *(f32x4*)o = x0; *(f32x4*)(o + 4) = x1; }
            const unsigned ww[4] = {cvt_pk_bf16(x0.x, x0.y), cvt_pk_bf16(x0.z, x0.w), cvt_pk_bf16(x1.x, x1.y), cvt_pk_bf16(x1.z, x1.w)};
#pragma unroll
            for (int j = 0; j < 4; ++j) { vT[(d8 + 2 * j) * PW + sI] = (bf16_t)(ww[j] & 0xffffu); vT[(d8 + 2 * j + 1) * PW + sI] = (bf16_t)(ww[j] >> 16); } }
    }
    __syncthreads();
#pragma unroll
    for (int tt = 0; tt < 8; ++tt) {
        const f32x4 acc = mma16(Wb + tt * 16 * PW, PW, vT + wave * 16 * PW, PW, tt / 2 + 1, (f32x4){0.f, 0.f, 0.f, 0.f}, fr, fq);
#pragma unroll
        for (int j = 0; j < 4; ++j) Os[(tt * 16 + fq * 4 + j) * 132 + wave * 16 + fr] = acc[j];
    }
    __syncthreads();
    {
        const int d0 = (tid & 15) * 8, tb = 4 * (tid >> 4);
        bf16_t* mix = (bf16_t*)(p.ws + WS_MIX);
#pragma unroll
        for (int i = 0; i < 4; ++i) { const int t = tb + i; const float bias = bv[i];
            const f32x4 a0 = *(const LAS f32x4*)(Os + t * 132 + d0), a1 = *(const LAS f32x4*)(Os + t * 132 + d0 + 4);
            const u32x4 uw = uwv[i];
            const f32x4 o0 = (a0 + bias) * (f32x4){bf_lo(uw.x), bf_hi(uw.x), bf_lo(uw.y), bf_hi(uw.y)};
            const f32x4 o1 = (a1 + bias) * (f32x4){bf_lo(uw.z), bf_hi(uw.z), bf_lo(uw.w), bf_hi(uw.w)};
            u32x4 w; w.x = cvt_pk_bf16(o0.x, o0.y); w.y = cvt_pk_bf16(o0.z, o0.w); w.z = cvt_pk_bf16(o1.x, o1.y); w.w = cvt_pk_bf16(o1.z, o1.w);
            st16_wt(mix + (size_t)(t0 + t) * D + 512 + h * 128 + d0, w); }
    }
    __syncthreads();
}
__device__ __forceinline__ void sg_s_row(const Params& p, int seq, int lane) {
    const int row = MP + seq, c0 = 8 * lane, h = c0 >> 7;
    const bf16_t* pev = (const bf16_t*)(p.ws + WS_H);
    const u32x4 w = *(const u32x4*)(pev + (size_t)row * PEV_LD + 2048 + c0);
    float f[8] = {bf_lo(w.x), bf_hi(w.x), bf_lo(w.y), bf_hi(w.y), bf_lo(w.z), bf_hi(w.z), bf_lo(w.w), bf_hi(w.w)};
    float sm = 0.f;
#pragma unroll
    for (int j = 0; j < 8; ++j) sm += f[j];
    const float mean = wave_sum(sm) * (1.f / 512.f);
    float sq = 0.f;
#pragma unroll
    for (int j = 0; j < 8; ++j) { f[j] -= mean; sq += f[j] * f[j]; }
    const float rs = rsqrtf(wave_sum(sq) * (1.f / 512.f) + EPS);
    const float w00 = p.in[14][(size_t)h * 16384], b0 = p.in[15][h * 128];
    const u32x4 uw = *(const u32x4*)(pev + (size_t)row * PEV_LD + 1536 + c0);
    const float uf[8] = {bf_lo(uw.x), bf_hi(uw.x), bf_lo(uw.y), bf_hi(uw.y), bf_lo(uw.z), bf_hi(uw.z), bf_lo(uw.w), bf_hi(uw.w)};
    float vnv[8], ov[8];
#pragma unroll
    for (int j = 0; j < 8; ++j) { vnv[j] = f[j] * rs * p.in[12][c0 + j] + p.in[13][c0 + j]; ov[j] = uf[j] * (w00 * vnv[j] + b0); }
    float* so = p.out + O_SGVS + (size_t)seq * 512 + c0;
    *(f32x4*)so = (f32x4){vnv[0], vnv[1], vnv[2], vnv[3]}; *(f32x4*)(so + 4) = (f32x4){vnv[4], vnv[5], vnv[6], vnv[7]};
    u32x4 o; o.x = cvt_pk_bf16(ov[0], ov[1]); o.y = cvt_pk_bf16(ov[2], ov[3]); o.z = cvt_pk_bf16(ov[4], ov[5]); o.w = cvt_pk_bf16(ov[6], ov[7]);
    st16_wt((bf16_t*)(p.ws + WS_MIX) + (size_t)row * D + 512 + c0, o);
}

__device__ __forceinline__ void conv_ln_rows(const Params& p, const LAS float* cout, int ntok, int rowbase, int wave, int lane) {
    const int c0 = 8 * lane;
    const f32x4 g0 = *(const f32x4*)(p.in[20] + c0), g1 = *(const f32x4*)(p.in[20] + c0 + 4);
    const f32x4 b0 = *(const f32x4*)(p.in[21] + c0), b1 = *(const f32x4*)(p.in[21] + c0 + 4);
#pragma unroll 4
    for (int t = wave; t < ntok; t += 8) {
        f32x4 x0 = *(const LAS f32x4*)(cout + t * 512 + c0), x1 = *(const LAS f32x4*)(cout + t * 512 + c0 + 4);
        float sm = (x0.x + x0.y) + (x0.z + x0.w) + (x1.x + x1.y) + (x1.z + x1.w);
        float sq = (x0.x * x0.x + x0.y * x0.y) + (x0.z * x0.z + x0.w * x0.w) + (x1.x * x1.x + x1.y * x1.y) + (x1.z * x1.z + x1.w * x1.w);
#pragma unroll
        for (int o = 1; o < 64; o <<= 1) { sm += __shfl_xor(sm, o); sq += __shfl_xor(sq, o); }
        const float mean = sm * (1.f / 512.f), var = fmaxf(sq * (1.f / 512.f) - mean * mean, 0.f);
        const float rs = rsqrtf(var + EPS);
        x0 = (x0 - mean) * rs * g0 + b0; x1 = (x1 - mean) * rs * g1 + b1;
        u32x4 w; w.x = cvt_pk_bf16(fsilu(x0.x), fsilu(x0.y)); w.y = cvt_pk_bf16(fsilu(x0.z), fsilu(x0.w)); w.z = cvt_pk_bf16(fsilu(x1.x), fsilu(x1.y)); w.w = cvt_pk_bf16(fsilu(x1.z), fsilu(x1.w));
        st16_wt((bf16_t*)(p.ws + WS_MIX) + (size_t)(rowbase + t) * D + c0, w);
    }
}
__device__ __forceinline__ void conv_item(const Params& p, LAS unsigned char* L, int item) {
    const int tid = threadIdx.x, b = item >> 6, tb = (item & 63) * 32;
    LAS unsigned* gin = (LAS unsigned*)L;
    LAS float* cout = (LAS float*)(L + 63488);
    const bf16_t* pod = (const bf16_t*)(p.ws + WS_H);
    {
        u32x4 wst[8];
#pragma unroll
        for (int k = 0; k < 8; ++k) { const int i = tid + 512 * k, r = i >> 6, c8 = (i & 63) * 8, t = tb - 30 + r;
            wst[k] = (u32x4){0u, 0u, 0u, 0u};
            if (i < 62 * 64 && t >= 0) wst[k] = *(const u32x4*)(pod + (size_t)(b * SEQ + t) * POD_LD + c8); }
#pragma unroll
        for (int k = 0; k < 8; ++k) { const int i = tid + 512 * k, r = i >> 6, c8 = (i & 63) * 8;
            if (i < 62 * 64) *(LAS u32x4*)(gin + r * 256 + (c8 >> 1)) = wst[k]; }
    }
    const int cp = tid & 255, half = tid >> 8;
    f32x2 w[31];
#pragma unroll
    for (int j = 0; j < 31; ++j) w[j] = *(const f32x2*)(p.in[18] + j * 512 + 2 * cp);
    const f32x2 bias = *(const f32x2*)(p.in[19] + 2 * cp);
    __syncthreads();
#pragma unroll 1
    for (int g = 0; g < 4; ++g) {
        const int tt = half * 16 + g * 4;
        f32x2 a[4];
#pragma unroll
        for (int i = 0; i < 4; ++i) a[i] = bias;
#pragma unroll
        for (int jj = 0; jj < 34; ++jj) { const unsigned x = gin[(tt + jj) * 256 + cp]; const f32x2 xv = (f32x2){bf_lo(x), bf_hi(x)};
#pragma unroll
            for (int i = 0; i < 4; ++i) { const int j = jj - i; if (j >= 0 && j <= 30) a[i] += w[j] * xv; } }
#pragma unroll
        for (int i = 0; i < 4; ++i) *(LAS f32x2*)(cout + (tt + i) * 512 + 2 * cp) = a[i];
    }
    __syncthreads();
    conv_ln_rows(p, cout, 32, b * SEQ + tb, tid >> 6, tid & 63);
    __syncthreads();
}
__device__ __forceinline__ void conv_s_item(const Params& p, LAS unsigned char* L, int seq) {
    const int c = threadIdx.x;
    LAS float* cout = (LAS float*)L;
    const bf16_t* pod = (const bf16_t*)(p.ws + WS_H);
    const float* st = p.in[3] + (size_t)seq * 30 * 512 + c; float* so = p.out + O_CONVS + (size_t)seq * 30 * 512 + c;
    float xs[30], wv[31];
#pragma unroll
    for (int j = 0; j < 30; ++j) { xs[j] = st[j * 512]; wv[j] = p.in[18][j * 512 + c]; }
    wv[30] = p.in[18][30 * 512 + c];
    float a = p.in[19][c] + wv[30] * bf1(pod[(size_t)(MP + seq) * POD_LD + c]);
#pragma unroll
    for (int j = 0; j < 30; ++j) a += wv[j] * xs[j];
#pragma unroll
    for (int j = 1; j < 30; ++j) so[(j - 1) * 512] = xs[j];
    cout[c] = a;
    __syncthreads();
    conv_ln_rows(p, cout, 1, MP + seq, threadIdx.x >> 6, threadIdx.x & 63);
    __syncthreads();
}
constexpr int PP = 520;
struct PoolB { bf16x8 b[4][4]; float sc[4]; };
__device__ __forceinline__ void pool_loadb(const Params& p, PoolB& B) {
    const int tid = threadIdx.x, wave = tid >> 6, lane = tid & 63, fr = lane & 15, fq = lane >> 4, g = wave >> 1;
    const bf16_t* Wp = (const bf16_t*)(p.ws + WS_WPOOL);
#pragma unroll
    for (int dt = 0; dt < 4; ++dt) { const int col = wave * 64 + dt * 16 + fr; B.sc[dt] = p.in[23][col];
#pragma unroll
        for (int ks = 0; ks < 4; ++ks) B.b[dt][ks] = *(const bf16x8*)(Wp + (size_t)col * 512 + g * 128 + ks * 32 + fq * 8); }
}
template <int NT>
__device__ __forceinline__ void pool_mma(const Params& p, const PoolB& B, const LAS bf16_t* Pd, LAS bf16_t* Ob, int rowbase) {
    const int tid = threadIdx.x, wave = tid >> 6, lane = tid & 63, fr = lane & 15, fq = lane >> 4, g = wave >> 1;
#pragma unroll
    for (int dt = 0; dt < 4; ++dt) {
        const int col = wave * 64 + dt * 16 + fr;
#pragma unroll
        for (int tt = 0; tt < NT / 16; ++tt) {
            f32x4 acc = (f32x4){0.f, 0.f, 0.f, 0.f};
#pragma unroll
            for (int ks = 0; ks < 4; ++ks) { const bf16x8 a = *(const LAS bf16x8*)(Pd + (tt * 16 + fr) * PP + g * 128 + ks * 32 + fq * 8);
                acc = __builtin_amdgcn_mfma_f32_16x16x32_bf16(a, B.b[dt][ks], acc, 0, 0, 0); }
            const unsigned w0 = cvt_pk_bf16(acc[0] * B.sc[dt], acc[1] * B.sc[dt]), w1 = cvt_pk_bf16(acc[2] * B.sc[dt], acc[3] * B.sc[dt]);
            LAS bf16_t* o = Ob + (tt * 16 + fq * 4) * PP + col;
            o[0] = (bf16_t)(w0 & 0xffffu); o[PP] = (bf16_t)(w0 >> 16); o[2 * PP] = (bf16_t)(w1 & 0xffffu); o[3 * PP] = (bf16_t)(w1 >> 16);
        }
    }
    __syncthreads();
    bf16_t* mix = (bf16_t*)(p.ws + WS_MIX);
    for (int i = tid; i < NT * 64; i += 512) { const int r = i >> 6, c8 = (i & 63) * 8;
        st16_wt(mix + (size_t)(rowbase + r) * D + 512 + c8, *(const LAS u32x4*)(Ob + r * PP + c8)); }
}
constexpr int PNT = 64;
template <int WIN>
__device__ __forceinline__ void pool_body(const bf16_t* base, LAS bf16_t* Pd, int tb) {
    float xv[WIN + PNT - 1];
#pragma unroll
    for (int i = 0; i < WIN + PNT - 1; ++i) { const int t = tb - (WIN - 1) + i; xv[i] = (t >= 0) ? bf1(base[(size_t)t * POD_LD]) : 0.f; }
    float s = 0.f;
#pragma unroll
    for (int i = 0; i < WIN - 1; ++i) s += xv[i];
#pragma unroll
    for (int tt = 0; tt < PNT; ++tt) { const float x = xv[WIN - 1 + tt]; s += x; const int t = tb + tt;
        const float inv = (t + 1 < WIN) ? 1.f / (float)(t + 1) : 1.f / (float)WIN;
        const float pv = s * inv - x;
        Pd[tt * PP] = (bf16_t)(cvt_pk_bf16(pv, 0.f) & 0xffffu);
        s -= xv[tt]; }
}
__device__ __forceinline__ void pool_item(const Params& p, LAS unsigned char* L, int item) {
    const int c = threadIdx.x, b = item >> 5, tb = (item & 31) * PNT, g = c >> 7;
    const bf16_t* base = (const bf16_t*)(p.ws + WS_H) + (size_t)(b * SEQ) * POD_LD + 512 + c;
    LAS bf16_t* Pd = (LAS bf16_t*)L; LAS bf16_t* Ob = Pd + PNT * PP;
    PoolB B; pool_loadb(p, B);
    if (g == 0) pool_body<2>(base, Pd + c, tb); else if (g == 1) pool_body<4>(base, Pd + c, tb); else if (g == 2) pool_body<8>(base, Pd + c, tb); else pool_body<16>(base, Pd + c, tb);
#if defined(PROBEP) && PROBEP == 1
    asm volatile("" ::: "memory");
    if (g == 0) pool_body<2>(base, Pd + c, tb); else if (g == 1) pool_body<4>(base, Pd + c, tb); else if (g == 2) pool_body<8>(base, Pd + c, tb); else pool_body<16>(base, Pd + c, tb);
#endif
    __syncthreads();
    pool_mma<PNT>(p, B, Pd, Ob, b * SEQ + tb);
    __syncthreads();
#if defined(PROBEP) && PROBEP == 2
    pool_mma<PNT>(p, B, Pd, Ob, b * SEQ + tb);
    __syncthreads();
#endif
}
__device__ __forceinline__ void pool_s_item(const Params& p, LAS unsigned char* L, int item) {
    const int c = threadIdx.x, win = 2 << (c >> 7);
    LAS bf16_t* Pd = (LAS bf16_t*)L; LAS bf16_t* Ob = Pd + 32 * PP;
    PoolB B; pool_loadb(p, B);
#pragma unroll 1
    for (int q0 = 0; q0 < 16; q0 += 4) {
        float sv[4][15], xq[4];
#pragma unroll
        for (int qq = 0; qq < 4; ++qq) { const int seq = item * 16 + q0 + qq; const float* st = p.in[4] + (size_t)seq * 15 * 512 + c;
            xq[qq] = bf1(((const bf16_t*)(p.ws + WS_H))[(size_t)(MP + seq) * POD_LD + 512 + c]);
#pragma unroll
            for (int j = 0; j < 15; ++j) sv[qq][j] = st[j * 512]; }
#pragma unroll
        for (int qq = 0; qq < 4; ++qq) { const int seq = item * 16 + q0 + qq; float* so = p.out + O_POOLS + (size_t)seq * 15 * 512 + c;
            float tot = xq[qq];
#pragma unroll
            for (int j = 0; j < 15; ++j) { if (j >= 1) so[(j - 1) * 512] = sv[qq][j]; if (15 - j <= win - 1) tot += sv[qq][j]; }
            const float pv = tot / (float)win - xq[qq];
            Pd[(q0 + qq) * PP + c] = (bf16_t)(cvt_pk_bf16(pv, 0.f) & 0xffffu); }
    }
    __syncthreads();
    pool_mma<16>(p, B, Pd, Ob, MP + item * 16);
    __syncthreads();
}

__device__ __forceinline__ void skinny_resid_item(const Params& p, LAS unsigned char* L, const bf16_t* A, const bf16_t* Bt, int K, float scale, const float* xin_s  , int item) {
    const int tid = threadIdx.x, wave = tid >> 6, lane = tid & 63, fr = lane & 15, fq = lane >> 4;
    const int rg = item & 7, cgp = item >> 3;
    const int kw = K >> 3, ksteps = kw >> 5;
    const bf16_t* ap = A + (size_t)(rg * 16 + fr) * K + wave * kw + fq * 8;
    const bf16_t* bp = Bt + (size_t)(cgp * 64 + fr) * K + wave * kw + fq * 8;
    f32x4 acc[4];
#pragma unroll
    for (int n = 0; n < 4; ++n) acc[n] = (f32x4){0.f, 0.f, 0.f, 0.f};
#pragma unroll 6
    for (int ks = 0; ks < ksteps; ++ks) {
        const bf16x8 a = *(const bf16x8*)(ap + ks * 32);
#pragma unroll
        for (int n = 0; n < 4; ++n) { const bf16x8 b = *(const bf16x8*)(bp + (size_t)n * 16 * K + ks * 32); acc[n] = __builtin_amdgcn_mfma_f32_16x16x32_bf16(a, b, acc[n], 0, 0, 0); }
    }
    LAS float* red = (LAS float*)L;
#pragma unroll
    for (int n = 0; n < 4; ++n)
#pragma unroll
        for (int j = 0; j < 4; ++j) red[wave * 1024 + (fq * 4 + j) * 64 + n * 16 + fr] = acc[n][j];
    __syncthreads();
    const int o = tid * 2, r = o >> 6, c = o & 63;
    float s0 = 0.f, s1 = 0.f;
#pragma unroll
    for (int w = 0; w < 8; ++w) { const f32x2 v = *(const LAS f32x2*)(red + w * 1024 + o); s0 += v.x; s1 += v.y; }
    const int lrow = rg * 16 + r, row = MP + lrow, col = cgp * 64 + c;
    unsigned* xbp = (unsigned*)((bf16_t*)(p.ws + WS_XB) + (size_t)row * D + col);
    f32x2 xi;
    if (xin_s) xi = *(const f32x2*)(xin_s + (size_t)lrow * D + col); else { const unsigned w = *xbp; xi = (f32x2){bf_lo(w), bf_hi(w)}; }
    const float x0 = xi.x + scale * s0, x1 = xi.y + scale * s1;
    *xbp = cvt_pk_bf16(x0, x1);
    float sq = x0 * x0 + x1 * x1;
#pragma unroll
    for (int of = 1; of < 32; of <<= 1) sq += __shfl_xor(sq, of);
    if ((tid & 31) == 0) ((float*)(p.ws + WS_SSQ))[(size_t)row * 16 + cgp] = sq;
    __syncthreads();
}

#define XB_TMO      128
#define XB_XCNT(j)  (256  + 64 * (j))
#define XB_XSUB(j)  (1280 + 64 * (j))
#define XB_XGEN(j)  (2304 + 64 * (j))
#define XB_TOP      3328
#define XB_TOPGEN   3392
#define XCD_BAR_WORDS 3456
#define XB_SPIN_CAP (1u << 20)
__device__ __forceinline__ unsigned xb_ld(unsigned* p)              { return __hip_atomic_load(p, __ATOMIC_RELAXED, __HIP_MEMORY_SCOPE_AGENT); }
__device__ __forceinline__ unsigned xb_add(unsigned* p, unsigned v) { return __hip_atomic_fetch_add(p, v, __ATOMIC_RELAXED, __HIP_MEMORY_SCOPE_AGENT); }
__device__ __forceinline__ unsigned xb_xcc_id() { return (unsigned)__builtin_amdgcn_s_getreg((3 << 11) | 20) & 0xFu; }
#define XB_SPIN(cond, bar) do { unsigned _sp = 0; while (cond) { __builtin_amdgcn_s_sleep(1); \
    if ((++_sp & 255u) == 0u) { if (xb_ld(&(bar)[XB_TMO])) break; if (_sp > XB_SPIN_CAP) { atomicAdd(&(bar)[XB_TMO], 1u); break; } } } } while (0)
struct XcdBarrier { unsigned* bar; unsigned x; volatile LAS unsigned* st; };
__device__ __forceinline__ XcdBarrier xcd_barrier_post(unsigned* bar, volatile LAS unsigned* st) {
    XcdBarrier b; b.bar = bar; b.x = xb_xcc_id(); b.st = st;
    if (threadIdx.x == 0) (void)xb_add(&bar[XB_XCNT(b.x)], 1u);
    return b;
}
__device__ __forceinline__ void xcd_barrier_complete(unsigned* bar, unsigned x, unsigned& nloc, unsigned& nx) {
    const unsigned G = gridDim.x * gridDim.y * gridDim.z;
    unsigned sum, cnt, mine, sp = 0u;
    for (;;) {
        sum = 0u; cnt = 0u; mine = 0u;
#pragma unroll
        for (unsigned j = 0; j < 16; ++j) { const unsigned c = xb_ld(&bar[XB_XCNT(j)]); sum += c; cnt += (c > 0u) ? 1u : 0u; mine = (j == x) ? c : mine; }
        if (sum == G) break;
        __builtin_amdgcn_s_sleep(1);
        if ((++sp & 255u) == 0u) { if (xb_ld(&bar[XB_TMO])) break; if (sp > XB_SPIN_CAP) { atomicAdd(&bar[XB_TMO], 1u); break; } }
    }
    nloc = mine > 0u ? mine : 1u; nx = cnt > 0u ? cnt : 1u;
}
__device__ __forceinline__ void xcd_barrier(const XcdBarrier& b) {
    asm volatile("s_waitcnt vmcnt(0)" ::: "memory");
    __syncthreads();
    if (threadIdx.x == 0) {
        unsigned* bar = b.bar;
        __builtin_amdgcn_s_waitcnt(0);
        unsigned nloc = b.st[0], nx = b.st[1];
        if (nloc == 0u) { xcd_barrier_complete(bar, b.x, nloc, nx); b.st[0] = nloc; b.st[1] = nx; }
        const unsigned old = xb_add(&bar[XB_XSUB(b.x)], 1u);
        const unsigned gen = old / nloc;
        if (old + 1u == (gen + 1u) * nloc) {
            __builtin_amdgcn_fence(__ATOMIC_RELEASE, "agent");
            asm volatile("s_waitcnt vmcnt(0)" ::: "memory");
            const unsigned og = xb_add(&bar[XB_TOP], 1u);
            const unsigned tg = og / nx;
            if (og + 1u == (tg + 1u) * nx) xb_add(&bar[XB_TOPGEN], 1u);
            else XB_SPIN(xb_ld(&bar[XB_TOPGEN]) == tg, bar);
            __builtin_amdgcn_fence(__ATOMIC_ACQUIRE, "agent");
            xb_add(&bar[XB_XGEN(b.x)], 1u);
            asm volatile("s_waitcnt vmcnt(0)" ::: "memory");
        } else {
            XB_SPIN(xb_ld(&bar[XB_XGEN(b.x)]) == gen, bar);
            __builtin_amdgcn_fence(__ATOMIC_ACQUIRE, "agent");
            asm volatile("s_waitcnt vmcnt(0)" ::: "memory");
        }
    }
    __syncthreads();
}

__device__ __forceinline__ void ffn_in_phase(const Params& p, LAS unsigned char* L, int idx, int lo1, int hi1, int lo2, int hi2) {
    pg8::Gemm g{(const bf16_t*)(p.ws + WS_XB), (const bf16_t*)(p.ws + WS_WFFIN) + (size_t)idx * 5632 * 1024, MPAD, 5632, 1024};
    pg8::StaticOrder S; S.init(MPAD, 5632, gridDim.x, blockIdx.x);
    EpiFfnIn E{(bf16_t*)(p.ws + WS_H), (const float*)(p.ws + WS_SSQ)};
    pg8::gemm_phase<EpiFfnIn>(L, g, S, E);
    tail_prep(p, L, (MPAD / 256) * 22, lo1, hi1, lo2, hi2);
}
template <bool FIRST>
__device__ __forceinline__ void resid_phase(const Params& p, LAS unsigned char* L, const bf16_t* A, const bf16_t* Bt, int K, float scale) {
    pg8::Gemm g{A, Bt, MP, 1024, K};
    pg8::StaticOrder S; S.init(MP, 1024, gridDim.x, blockIdx.x);
    if (p.dry) scale = 0.f;
    EpiResid<FIRST> E{p.in[0], (bf16_t*)(p.ws + WS_XB), (float*)(p.ws + WS_SSQ), scale};
    pg8::gemm_phase<EpiResid<FIRST>>(L, g, S, E);
    for (int it = (int)gridDim.x - 1 - (int)blockIdx.x; it < 128; it += gridDim.x) skinny_resid_item(p, L, A + (size_t)MP * K, Bt, K, scale, FIRST ? p.in[1] : nullptr, it);
}

__global__ void __launch_bounds__(512, 2) mk_fwd(Params p) {
    extern __shared__ __attribute__((aligned(16))) unsigned char lds_raw[];
    LAS unsigned char* L = (LAS unsigned char*)lds_raw;
    const int tid = threadIdx.x, G = gridDim.x, bx = blockIdx.x;
    const int lo = p.ph_lo, hi = p.ph_hi;
    int ph = 0;
#if MK_MULTI
#define SEAM() do { ++ph; } while (0)
#else
    if (tid < 4) ((LAS unsigned*)(L + LDS_BYTES - 16))[tid] = 0u;
    __syncthreads();
    const XcdBarrier xbar = xcd_barrier_post((unsigned*)(p.ws + WS_BAR), (volatile LAS unsigned*)(L + LDS_BYTES - 16));
    if (p.ph_hi < 0) cg::this_grid().sync();
#define SEAM() do { ++ph; xcd_barrier(xbar); } while (0)
#endif
#define IN() (lo <= ph && ph < hi)
    const bf16_t* XB = (const bf16_t*)(p.ws + WS_XB);
    const bf16_t* Hb = (const bf16_t*)(p.ws + WS_H);
    const bf16_t* MIX = (const bf16_t*)(p.ws + WS_MIX);
    const bf16_t* WFFOUT = (const bf16_t*)(p.ws + WS_WFFOUT);

    if (IN()) phase_prep(p, L);
    SEAM();
    if (IN()) ffn_in_phase(p, L, 0, 5632, 6336, 8448, 9408);
    SEAM();
    if (IN()) resid_phase<true>(p, L, Hb, WFFOUT, DFF, 0.5f);
    SEAM();
    if (IN()) {
        pg8::Gemm g{XB, (const bf16_t*)(p.ws + WS_WEVIN), MPAD, EVN, 1024};
        pg8::StaticOrder S; S.init(MPAD, EVN, G, bx);
        EpiEvIn E{(bf16_t*)(p.ws + WS_H), (float*)(p.ws + WS_Z), (const float*)(p.ws + WS_SSQ)};
        pg8::gemm_phase<EpiEvIn>(L, g, S, E);
        tail_prep(p, L, (MPAD / 256) * 11, 1408, 2816, 0, 0);
    }
    SEAM();
    if (IN()) {
        for (int it = bx; it < 1024; it += G) gla_a_item(p, L, it);
        for (int sl = bx; sl < 512; sl += G) sg_item(p, L, (G & 7) ? sl : (sl & 7) * 64 + (sl >> 3));
        for (int s = bx * 8 + (tid >> 6); s < NS; s += G * 8) sg_s_row(p, s, tid & 63);
    }
    SEAM();
    if (IN()) { for (int it = bx; it < 512; it += G) gla_scan_item(p, it); }
    SEAM();
    if (IN()) {
        for (int it = bx; it < 1024; it += G) gla_c_item(p, L, it);
        for (int it = bx; it < 512; it += G) gla_s_item(p, L, it);
    }
    SEAM();
    if (IN()) resid_phase<false>(p, L, MIX, (const bf16_t*)(p.ws + WS_WEVOUT), 1024, 1.0f);
    SEAM();
    if (IN()) ffn_in_phase(p, L, 1, 6336, 7040, 2816, 4224);
    SEAM();
    if (IN()) resid_phase<false>(p, L, Hb, WFFOUT + (size_t)1 * 1024 * 2816, DFF, 0.5f);
    SEAM();
    if (IN()) ffn_in_phase(p, L, 2, 7040, 7744, 9408, 10112);
    SEAM();
    if (IN()) resid_phase<false>(p, L, Hb, WFFOUT + (size_t)2 * 1024 * 2816, DFF, 0.5f);
    SEAM();
    if (IN()) {
        pg8::Gemm g{XB, (const bf16_t*)(p.ws + WS_WODIN), MPAD, ODN, 1024};
        pg8::StaticOrder S; S.init(MPAD, ODN, G, bx);
        EpiOdIn E{(bf16_t*)(p.ws + WS_H), p.out, (const float*)(p.ws + WS_SSQ)};
        pg8::gemm_phase<EpiOdIn>(L, g, S, E);
        tail_prep(p, L, (MPAD / 256) * 6, 4224, 5632, 0, 0);
    }
    SEAM();
    if (IN()) {
        for (int sl = bx; sl < 512; sl += G) conv_item(p, L, (G & 7) ? sl : (sl & 7) * 64 + (sl >> 3));
#if defined(PROBE13) && PROBE13 == 1
        for (int it = bx; it < 512; it += G) conv_item(p, L, it);
#endif
        for (int it = bx; it < NS; it += G) conv_s_item(p, L, it);
#if defined(PROBE13) && PROBE13 == 3
        for (int it = bx; it < NS; it += G) conv_s_item(p, L, it);
#endif
        for (int sl = bx; sl < 256; sl += G) pool_item(p, L, (G & 7) ? sl : (sl & 7) * 32 + (sl >> 3));
        for (int it = G - 1 - bx; it < 8; it += G) pool_s_item(p, L, it);
    }
    SEAM();
    if (IN()) resid_phase<false>(p, L, MIX, (const bf16_t*)(p.ws + WS_WODOUT), 1024, 1.0f);
    SEAM();
    if (IN()) ffn_in_phase(p, L, 3, 7744, 8448, 0, 0);
    SEAM();
    if (IN()) resid_phase<false>(p, L, Hb, WFFOUT + (size_t)3 * 1024 * 2816, DFF, 0.5f);
    SEAM();
    if (IN()) {
        const int lane = tid & 63; const float* ssq = (const float*)(p.ws + WS_SSQ);
        const f32x4 g0[2] = {*(const f32x4*)(p.in[25] + 8 * lane), *(const f32x4*)(p.in[25] + 8 * lane + 512)};
        const f32x4 g1[2] = {*(const f32x4*)(p.in[25] + 8 * lane + 4), *(const f32x4*)(p.in[25] + 8 * lane + 516)};
        for (int row = bx * 8 + (tid >> 6); row < MT; row += 2 * G * 8) {
            const int row2 = row + G * 8; const bool has2 = row2 < MT; const int r2 = has2 ? row2 : row;
            u32x4 w[2][2]; f32x4 sq[2];
#pragma unroll
            for (int j = 0; j < 2; ++j) { w[0][j] = *(const u32x4*)(XB + (size_t)row * D + 8 * lane + 512 * j); w[1][j] = *(const u32x4*)(XB + (size_t)r2 * D + 8 * lane + 512 * j); }
            sq[0] = *(const f32x4*)(ssq + (size_t)row * 16 + 4 * (lane & 3)); sq[1] = *(const f32x4*)(ssq + (size_t)r2 * 16 + 4 * (lane & 3));
#pragma unroll
            for (int q = 0; q < 2; ++q) {
                float t = (sq[q].x + sq[q].y) + (sq[q].z + sq[q].w); t += __shfl_xor(t, 1); t += __shfl_xor(t, 2);
                const float rs = rsqrtf(t * (1.f / 1024.f) + EPS);
                if (q == 0 || has2) {
                    float* o = p.out + O_Y + (size_t)(q ? r2 : row) * D + 8 * lane;
#pragma unroll
                    for (int j = 0; j < 2; ++j) { const u32x4 x = w[q][j];
                        *(f32x4*)(o + 512 * j) = (f32x4){bf_lo(x.x), bf_hi(x.x), bf_lo(x.y), bf_hi(x.y)} * rs * g0[j];
                        *(f32x4*)(o + 512 * j + 4) = (f32x4){bf_lo(x.z), bf_hi(x.z), bf_lo(x.w), bf_hi(x.w)} * rs * g1[j]; }
                }
            }
        }
    }
#undef IN
#undef SEAM
}
constexpr int N_PHASES = 18;

extern "C" void kernel_launch(void* const* d_in, const int* in_sizes, int n_in, void* d_out, int out_size, void* d_ws, size_t ws_size, hipStream_t stream) {
    static int grid = 0;
    if (grid == 0) {
        if (n_in != 26 || ws_size < WS_END) { fprintf(stderr, "kernel_launch: unexpected n_in %d / ws_size %zu (need %zu)\n", n_in, ws_size, (size_t)WS_END); grid = -1; return; }
        int dev = 0, cus = 0, per_cu = 0;
        hipGetDevice(&dev);
        hipDeviceGetAttribute(&cus, hipDeviceAttributeMultiprocessorCount, dev);
        if (hipFuncSetAttribute((const void*)mk_fwd, hipFuncAttributeMaxDynamicSharedMemorySize, LDS_BYTES) != hipSuccess) { fprintf(stderr, "kernel_launch: hipFuncSetAttribute failed\n"); grid = -1; return; }
        if (hipOccupancyMaxActiveBlocksPerMultiprocessor(&per_cu, (const void*)mk_fwd, 512, LDS_BYTES) != hipSuccess || per_cu < 1) { fprintf(stderr, "kernel_launch: occupancy query gave %d\n", per_cu); per_cu = 1; }
        (void)hipGetLastError();
        grid = cus * per_cu;
        fprintf(stderr, "kernel_launch: grid %d (cus %d x %d)\n", grid, cus, per_cu);
    }
    if (grid < 0) return;
    Params p{};
    for (int i = 0; i < 26; ++i) p.in[i] = (const float*)d_in[i];
    p.out = (float*)d_out; p.ws = (unsigned char*)d_ws;
#if MK_MULTI
    for (int ph = 0; ph < N_PHASES; ++ph) {
        int reps = 1;
#ifdef PROBE_EXTRA
        { const int ex[] = PROBE_EXTRA; for (unsigned i = 0; i < sizeof(ex) / sizeof(int); ++i) if (ex[i] == ph) ++reps; }
#endif
        for (int r = 0; r < reps; ++r) { p.ph_lo = ph; p.ph_hi = ph + 1; p.dry = r; hipLaunchKernelGGL(mk_fwd, dim3(grid), dim3(512), LDS_BYTES, stream, p); }
    }
#else
    p.ph_lo = 0; p.ph_hi = N_PHASES;
    if (hipMemsetAsync((char*)d_ws + WS_BAR, 0, XCD_BAR_WORDS * 4, stream) != hipSuccess) { fprintf(stderr, "kernel_launch: memset failed\n"); return; }
    void* args[] = {&p};
    hipError_t e = hipLaunchCooperativeKernel((const void*)mk_fwd, dim3(grid), dim3(512), args, LDS_BYTES, stream);
    if (e != hipSuccess) fprintf(stderr, "kernel_launch: cooperative launch failed: %s (grid %d)\n", hipGetErrorString(e), grid);
#endif
}
```

```cpp
#include <hip/hip_runtime.h>
#include <hip/hip_cooperative_groups.h>
#include <cstdio>
#include <cstdint>
namespace cg = cooperative_groups;

#define LAS __attribute__((address_space(3)))
typedef unsigned short bf16_t;
typedef short bf16x8 __attribute__((ext_vector_type(8)));
typedef float f32x4 __attribute__((ext_vector_type(4)));
typedef float f32x2 __attribute__((ext_vector_type(2)));
typedef unsigned u32x4 __attribute__((ext_vector_type(4)));
typedef unsigned u32x2 __attribute__((ext_vector_type(2)));

#ifndef MK_MULTI
#define MK_MULTI 0
#endif

constexpr int D = 1024, SEQ = 2048, MP = 16384, NS = 128, MT = 16512, MPAD = 16640, DFF = 2816;
constexpr int EVN = 2816, ODN = 1536, PEV_LD = 2816, POD_LD = 1024;
constexpr float EPS = 1e-6f;
constexpr size_t O_Y = 0, O_GLAP = 16908288, O_GLAS = 17170432, O_SGVP = 21364736, O_SGVS = 21889024,
                 O_CONVP = 21954560, O_CONVS = 22077440, O_POOLP = 24043520, O_POOLS = 24104960;
constexpr size_t WS_WFFIN = 0;
constexpr size_t WS_WFFOUT = WS_WFFIN + 4ull * 11534336;
constexpr size_t WS_WEVIN = WS_WFFOUT + 4ull * 5767168;
constexpr size_t WS_WEVOUT = WS_WEVIN + 5767168;
constexpr size_t WS_WODIN = WS_WEVOUT + 2097152;
constexpr size_t WS_WODOUT = WS_WODIN + 3145728;
constexpr size_t WS_WPOOL = WS_WODOUT + 2097152;
constexpr size_t WS_X = WS_WPOOL + 524288;
constexpr size_t WS_XB = WS_X + 68157440;
constexpr size_t WS_SSQ = WS_XB + 34078720;
constexpr size_t WS_H = WS_SSQ + 1064960;
constexpr size_t WS_Z = WS_H + 93716480;
constexpr size_t WS_MIX = WS_Z + 1064960;
constexpr size_t WS_KV = WS_MIX + 34078720;
constexpr size_t WS_DEC = WS_KV + 33554432;
constexpr size_t WS_BAR = WS_DEC + 262144;
constexpr size_t WS_END = WS_BAR + 16384;
constexpr int LDS_BYTES = 147456;

struct Params {
    const float* in[26];
    float* out;
    unsigned char* ws;
    int ph_lo, ph_hi, dry, pad;
};

typedef __bf16 bf16x2_t __attribute__((ext_vector_type(2)));
__device__ __forceinline__ unsigned cvt_pk_bf16(float lo, float hi) { const f32x2 v = {lo, hi}; const bf16x2_t b = __builtin_convertvector(v, bf16x2_t); return __builtin_bit_cast(unsigned, b); }
__device__ __forceinline__ float bf_lo(unsigned w) { return __uint_as_float(w << 16); }
__device__ __forceinline__ float bf_hi(unsigned w) { return __uint_as_float(w & 0xffff0000u); }
__device__ __forceinline__ float bf1(bf16_t b) { return __uint_as_float(((unsigned)b) << 16); }
__device__ __forceinline__ float wave_sum(float v) {
#pragma unroll
    for (int o = 1; o < 64; o <<= 1) v += __shfl_xor(v, o);
    return v;
}
__device__ __forceinline__ float fsigmoid(float x) { return __builtin_amdgcn_rcpf(1.f + __builtin_amdgcn_exp2f(-1.4426950408889634f * x)); }
__device__ __forceinline__ float fsilu(float x) { return x * fsigmoid(x); }
__device__ __forceinline__ float fgelu(float x) { return x * fsigmoid(1.5957691216057308f * (x + 0.044715f * x * x * x)); }
#define LDS_WAIT() asm volatile("s_waitcnt lgkmcnt(0)" ::: "memory")
__device__ __forceinline__ void st16_wt(void* ptr, u32x4 v) { asm volatile("global_store_dwordx4 %0, %1, off sc1\n\ts_nop 2" :: "v"(ptr), "v"(v) : "memory"); }

namespace pg8 {
constexpr int BM = 256, BK = 64, HALF = 128, HTB = HALF * BK * 2, STAGE_BYTES = 8 * HTB, NXCD = 8, WGM = 8;
__host__ __device__ __forceinline__ int lds_byte(int r, int c) { const int st = (r >> 4) * 2 + (c >> 5), rr = r & 15, cc = c & 31, ob = rr * 64 + cc * 2; return st * 1024 + (ob ^ (((ob >> 9) & 1) << 5)); }
__host__ __device__ __forceinline__ void stage_rc(int b, int& R, int& C) { const int st = b / 1024, sb = b % 1024, swz = sb ^ (((sb >> 9) & 1) << 5); R = (st >> 1) * 16 + swz / 64; C = (st & 1) * 32 + (swz % 64) / 2; }
__host__ __device__ __forceinline__ int perm32(int rho) { const int n = rho >> 4, i = rho & 15; return 8 * (i >> 2) + 4 * n + (i & 3); }
struct Unit { int pm, pn; };
struct Gemm { const bf16_t* A; const bf16_t* Bt; int M, N, K; };
struct StaticOrder {
    int nM, nN, nwg, G, c;
    __host__ __device__ void init(int M, int N, int G_, int c_) { nM = M / BM; nN = N / BM; nwg = nM * nN; G = G_; c = c_; }
    __host__ __device__ bool next(int i, Unit& u) const {
        const long L = (long)i * G + c; if (L >= nwg) return false;
        int wgid = (int)L; { const int q = nwg / NXCD, r = nwg % NXCD, xcd = wgid % NXCD, off = wgid / NXCD; wgid = (xcd < r ? xcd * (q + 1) : r * (q + 1) + (xcd - r) * q) + off; }
        const int nig = WGM * nN, gid = wgid / nig, fm = gid * WGM, gsz = (nM - fm) < WGM ? (nM - fm) : WGM;
        u.pm = fm + ((wgid % nig) % gsz); u.pn = (wgid % nig) / gsz; return true;
    }
};
template <class Epi, bool ALIGN_EPI = true>
__device__ __forceinline__ void gemm_phase(LAS unsigned char* lds, const Gemm g, const StaticOrder& S, const Epi& E) {
    const int tid = threadIdx.x, wid = __builtin_amdgcn_readfirstlane(tid >> 6), lane = tid & 63, wr = wid >> 2, wc = wid & 3, fr = lane & 15, fq = lane >> 4;
    const int K = g.K, nt = K / BK;
    unsigned voffA[2], voffB[2];
#pragma unroll
    for (int i = 0; i < 2; ++i) { int R, C; stage_rc(tid * 16 + i * 8192, R, C); const int Rb = Epi::PERM ? ((R & ~31) + perm32(R & 31)) : R;
        voffA[i] = (unsigned)(R * K + C) * 2u; voffB[i] = (unsigned)(Rb * K + C) * 2u; }
    const size_t kstep = (size_t)(BK * 2);
    const size_t hstep = (size_t)HALF * K * 2;
    const size_t tstep = 2 * hstep;
    const unsigned ldsw = (unsigned)wid * 1024u;
    const int aoff = lds_byte(wr * 64 + fr, fq * 8), boff = lds_byte(wc * 32 + fr, fq * 8);
#define PG8_SA(b, h) (((b) * 2 + (h)) * HTB)
#define PG8_SB(b, h) ((4 + (b) * 2 + (h)) * HTB)
#define PG8_STAGE(bufoff, gbase, voff) do { _Pragma("unroll") for (int _i = 0; _i < 2; ++_i) \
        __builtin_amdgcn_global_load_lds((const unsigned*)((const char*)(gbase) + (voff)[_i]), (LAS unsigned*)(lds + (bufoff) + ldsw + _i * 8192), 16, 0, 0); } while (0)
#define PG8_LDA(dst, b, h) do { _Pragma("unroll") for (int m = 0; m < 4; ++m) _Pragma("unroll") for (int k = 0; k < 2; ++k) dst[m][k] = *(const LAS bf16x8*)(lds + PG8_SA(b, h) + aoff + m * 2048 + k * 1024); } while (0)
#define PG8_LDB(dst, b, h) do { _Pragma("unroll") for (int n = 0; n < 2; ++n) _Pragma("unroll") for (int k = 0; k < 2; ++k) dst[n][k] = *(const LAS bf16x8*)(lds + PG8_SB(b, h) + boff + n * 2048 + k * 1024); } while (0)
#define PG8_MMA(ai, bj, At, Bt) do { __builtin_amdgcn_s_setprio(1); _Pragma("unroll") for (int m = 0; m < 4; ++m) _Pragma("unroll") for (int n = 0; n < 2; ++n) _Pragma("unroll") for (int k = 0; k < 2; ++k) \
        acc[ai][bj][m][n] = __builtin_amdgcn_mfma_f32_16x16x32_bf16(Bt[n][k], At[m][k], acc[ai][bj][m][n], 0, 0, 0); __builtin_amdgcn_s_setprio(0); } while (0)
#define PG8_WAIT_V(n) asm volatile("s_waitcnt vmcnt(" #n ")" ::: "memory")
#define PG8_WAIT_L(n) asm volatile("s_waitcnt lgkmcnt(" #n ")" ::: "memory")
#define PG8_BAR __builtin_amdgcn_s_barrier()
#define PG8_SCHED __builtin_amdgcn_sched_barrier(0)
    Unit cur, nxt; int ui = 0;
    if (!S.next(0, cur)) return;
    LAS float* rl = (LAS float*)(lds + STAGE_BYTES);
    { typename Epi::Raw raw0; E.pre_issue(cur, wr, fr, fq, raw0); E.pre_finish(raw0, rl, wr, wc, fr, fq); }
    f32x4 acc[2][2][4][2];
#pragma unroll
    for (int a = 0; a < 2; ++a)
#pragma unroll
        for (int b = 0; b < 2; ++b)
#pragma unroll
            for (int m = 0; m < 4; ++m)
#pragma unroll
                for (int n = 0; n < 2; ++n) acc[a][b][m][n] = (f32x4){0.f, 0.f, 0.f, 0.f};
    bf16x8 At[4][2], B0[2][2], B1[2][2];
    const char* cA = (const char*)g.A + (size_t)cur.pm * tstep; const char* cB = (const char*)g.Bt + (size_t)cur.pn * tstep;
    PG8_STAGE(PG8_SB(0, 0), cB, voffB); PG8_STAGE(PG8_SB(0, 1), cB + hstep, voffB); PG8_STAGE(PG8_SA(0, 0), cA, voffA); PG8_STAGE(PG8_SA(0, 1), cA + hstep, voffA);
    if (wr == 1) PG8_BAR;
    PG8_WAIT_V(2); PG8_BAR;
    PG8_STAGE(PG8_SB(1, 0), cB + kstep, voffB); PG8_STAGE(PG8_SA(1, 0), cA + kstep, voffA); PG8_STAGE(PG8_SB(1, 1), cB + hstep + kstep, voffB);
    PG8_WAIT_V(6); PG8_BAR;
    for (;;) {
        const bool has_next = S.next(ui + 1, nxt);
        const char* nA = has_next ? (const char*)g.A + (size_t)nxt.pm * tstep : cA; const char* nB = has_next ? (const char*)g.Bt + (size_t)nxt.pn * tstep : cB;
        for (int t = 0; t < nt; t += 2) {
            const bool last = (t == nt - 2);
            const char* a1 = cA + (size_t)(t + 1) * kstep;
            const char* a2 = last ? nA : cA + (size_t)(t + 2) * kstep; const char* b2 = last ? nB : cB + (size_t)(t + 2) * kstep;
            const char* a3 = a2 + kstep; const char* b3 = b2 + kstep;
            PG8_LDB(B0, 0, 0); PG8_LDB(B1, 0, 1); PG8_SCHED; PG8_LDA(At, 0, 0); PG8_STAGE(PG8_SA(1, 1), a1 + hstep, voffA);
            PG8_WAIT_V(8); PG8_WAIT_L(0); PG8_BAR; PG8_MMA(0, 0, At, B0); PG8_MMA(0, 1, At, B1); PG8_BAR; PG8_SCHED;
            PG8_LDA(At, 0, 1); PG8_STAGE(PG8_SB(0, 0), b2, voffB); PG8_STAGE(PG8_SB(0, 1), b2 + hstep, voffB); PG8_STAGE(PG8_SA(0, 0), a2, voffA);
            PG8_WAIT_V(8); PG8_WAIT_L(0); PG8_BAR; PG8_MMA(1, 0, At, B0); PG8_MMA(1, 1, At, B1); PG8_BAR; PG8_SCHED;
            PG8_LDB(B0, 1, 0); PG8_LDB(B1, 1, 1); PG8_SCHED; PG8_LDA(At, 1, 0); PG8_STAGE(PG8_SA(0, 1), a2 + hstep, voffA);
            PG8_WAIT_V(8); PG8_WAIT_L(0); PG8_BAR; PG8_MMA(0, 0, At, B0); PG8_MMA(0, 1, At, B1); PG8_BAR; PG8_SCHED;
            PG8_LDA(At, 1, 1); PG8_STAGE(PG8_SB(1, 0), b3, voffB); PG8_STAGE(PG8_SB(1, 1), b3 + hstep, voffB); PG8_STAGE(PG8_SA(1, 0), a3, voffA);
            PG8_WAIT_V(8); PG8_WAIT_L(0); PG8_BAR; PG8_MMA(1, 0, At, B0); PG8_MMA(1, 1, At, B1); PG8_BAR; PG8_SCHED;
        }
        if constexpr (ALIGN_EPI) { if (wr == 0) PG8_BAR; }
        typename Epi::Raw raw; if (has_next) E.pre_issue(nxt, wr, fr, fq, raw);
        E(acc, cur, wr, wc, fr, fq, rl + (ui & 1) * 256);
        if (has_next) E.pre_finish(raw, rl + ((ui + 1) & 1) * 256, wr, wc, fr, fq);
        if (!has_next) break;
#pragma unroll
        for (int a = 0; a < 2; ++a)
#pragma unroll
            for (int b = 0; b < 2; ++b)
#pragma unroll
                for (int m = 0; m < 4; ++m)
#pragma unroll
                    for (int n = 0; n < 2; ++n) acc[a][b][m][n] = (f32x4){0.f, 0.f, 0.f, 0.f};
        cur = nxt; cA = nA; cB = nB; ++ui;
        if constexpr (ALIGN_EPI) { if (wr == 1) PG8_BAR; }
    }
    PG8_WAIT_V(0);
    if constexpr (!ALIGN_EPI) { if (wr == 0) PG8_BAR; }
    PG8_BAR;
#undef PG8_SA
#undef PG8_SB
#undef PG8_STAGE
#undef PG8_LDA
#undef PG8_LDB
#undef PG8_MMA
#undef PG8_WAIT_V
#undef PG8_WAIT_L
#undef PG8_BAR
#undef PG8_SCHED
}
}
using pg8::Unit;

struct NoRaw {};
struct RstdRaw { f32x4 a, b; };
__device__ __forceinline__ void rstd_issue(const float* ssq, int pm, RstdRaw& r) {
    const float* sp = ssq + ((size_t)pm * 256 + (threadIdx.x >> 1)) * 16 + (threadIdx.x & 1) * 8;
    r.a = *(const f32x4*)sp; r.b = *(const f32x4*)(sp + 4);
}
__device__ __forceinline__ void rstd_finish(const RstdRaw& r, LAS float* dst) {
    float t = ((r.a.x + r.a.y) + (r.a.z + r.a.w)) + ((r.b.x + r.b.y) + (r.b.z + r.b.w));
    t += __shfl_xor(t, 1);
    if ((threadIdx.x & 1) == 0) dst[threadIdx.x >> 1] = rsqrtf(t * (1.f / 1024.f) + EPS);
}
__device__ __forceinline__ void unit_rstd(const float* ssq, int row0, int fq, float (&rs)[2][4]) {
    f32x4 q[2][4];
#pragma unroll
    for (int ai = 0; ai < 2; ++ai)
#pragma unroll
        for (int m = 0; m < 4; ++m) q[ai][m] = *(const f32x4*)(ssq + (size_t)(row0 + ai * 128 + m * 16) * 16 + 4 * fq);
#pragma unroll
    for (int ai = 0; ai < 2; ++ai)
#pragma unroll
        for (int m = 0; m < 4; ++m) { float t = (q[ai][m].x + q[ai][m].y) + (q[ai][m].z + q[ai][m].w); t += __shfl_xor(t, 16); t += __shfl_xor(t, 32); rs[ai][m] = rsqrtf(t * (1.f / 1024.f) + EPS); }
}
__device__ __forceinline__ float row_rstd(const float* ssq, int row) {
    const f32x4* p = (const f32x4*)(ssq + (size_t)row * 16);
    const f32x4 a = p[0], b = p[1], c = p[2], d = p[3];
    const float s = ((a.x + a.y) + (a.z + a.w)) + ((b.x + b.y) + (b.z + b.w)) + ((c.x + c.y) + (c.z + c.w)) + ((d.x + d.y) + (d.z + d.w));
    return rsqrtf(s * (1.f / 1024.f) + EPS);
}
struct EpiFfnIn {
    static constexpr bool PERM = true;
    bf16_t* H; const float* ssq;
    typedef RstdRaw Raw;
    __device__ __forceinline__ void pre_issue(const Unit& u, int wr, int fr, int fq, Raw& r) const { rstd_issue(ssq, u.pm, r); }
    __device__ __forceinline__ void pre_finish(const Raw& r, LAS float* dst, int wr, int wc, int fr, int fq) const { rstd_finish(r, dst); }
    __device__ __forceinline__ void operator()(const f32x4 (&acc)[2][2][4][2], const Unit& u, int wr, int wc, int fr, int fq, const LAS float* rl) const {
        const int row0 = u.pm * 256 + wr * 64 + fr, col0 = u.pn * 128 + wc * 32 + 8 * fq;
        float rsa[2][4];
#pragma unroll
        for (int ai = 0; ai < 2; ++ai)
#pragma unroll
            for (int m = 0; m < 4; ++m) rsa[ai][m] = rl[ai * 128 + wr * 64 + m * 16 + fr];
#pragma unroll
        for (int ai = 0; ai < 2; ++ai)
#pragma unroll
            for (int m = 0; m < 4; ++m) {
                const int row = row0 + ai * 128 + m * 16; const float rs = rsa[ai][m];
                const float cexp = -1.4426950408889634f * rs, rs2 = rs * rs;
                f32x2 A2[4], B2[4], E2[4], H2[4];
#pragma unroll
                for (int n = 0; n < 2; ++n) { const f32x4 a = acc[ai][0][m][n], b = acc[ai][1][m][n];
                    A2[2 * n] = (f32x2){a.x, a.y}; A2[2 * n + 1] = (f32x2){a.z, a.w}; B2[2 * n] = (f32x2){b.x, b.y}; B2[2 * n + 1] = (f32x2){b.z, b.w}; }
#pragma unroll
                for (int q = 0; q < 4; ++q) { const f32x2 t = A2[q] * cexp; E2[q].x = __builtin_amdgcn_exp2f(t.x); E2[q].y = __builtin_amdgcn_exp2f(t.y); }
#pragma unroll
                for (int q = 0; q < 4; ++q) { const f32x2 d = E2[q] + 1.0f; E2[q].x = __builtin_amdgcn_rcpf(d.x); E2[q].y = __builtin_amdgcn_rcpf(d.y); }
#pragma unroll
                for (int q = 0; q < 4; ++q) H2[q] = (A2[q] * B2[q]) * rs2 * E2[q];
                u32x4 w; w.x = cvt_pk_bf16(H2[0].x, H2[0].y); w.y = cvt_pk_bf16(H2[1].x, H2[1].y); w.z = cvt_pk_bf16(H2[2].x, H2[2].y); w.w = cvt_pk_bf16(H2[3].x, H2[3].y);
                st16_wt(H + (size_t)row * DFF + col0, w);
            }
    }
};
template <bool FIRST>
struct EpiResid {
    static constexpr bool PERM = true;
    const float* xin_p; bf16_t* XB; float* ssq; float scale;
    typedef NoRaw Raw;
    __device__ __forceinline__ void pre_issue(const Unit&, int, int, int, Raw&) const {}
    __device__ __forceinline__ void pre_finish(const Raw&, LAS float*, int, int, int, int) const {}
    __device__ __forceinline__ void operator()(const f32x4 (&acc)[2][2][4][2], const Unit& u, int wr, int wc, int fr, int fq, const LAS float*) const {
        const int row0 = u.pm * 256 + wr * 64 + fr, col0 = u.pn * 256 + wc * 32 + 8 * fq;
#pragma unroll
        for (int ai = 0; ai < 2; ++ai) {
            f32x4 r[4][2][2];
#pragma unroll
            for (int m = 0; m < 4; ++m)
#pragma unroll
                for (int bj = 0; bj < 2; ++bj) {
                    const size_t off = (size_t)(row0 + ai * 128 + m * 16) * D + col0 + bj * 128;
                    if (FIRST) { r[m][bj][0] = *(const f32x4*)(xin_p + off); r[m][bj][1] = *(const f32x4*)(xin_p + off + 4); }
                    else { const u32x4 w = *(const u32x4*)(XB + off);
                        r[m][bj][0] = (f32x4){bf_lo(w.x), bf_hi(w.x), bf_lo(w.y), bf_hi(w.y)}; r[m][bj][1] = (f32x4){bf_lo(w.z), bf_hi(w.z), bf_lo(w.w), bf_hi(w.w)}; }
                }
            asm volatile("" ::: "memory");
#pragma unroll
            for (int m = 0; m < 4; ++m) {
                const int row = row0 + ai * 128 + m * 16;
                float sq = 0.f;
#pragma unroll
                for (int bj = 0; bj < 2; ++bj) {
                    const f32x4 o0 = r[m][bj][0] + acc[ai][bj][m][0] * scale, o1 = r[m][bj][1] + acc[ai][bj][m][1] * scale;
                    sq += ((o0.x * o0.x + o0.y * o0.y) + (o0.z * o0.z + o0.w * o0.w)) + ((o1.x * o1.x + o1.y * o1.y) + (o1.z * o1.z + o1.w * o1.w));
                    u32x4 w; w.x = cvt_pk_bf16(o0.x, o0.y); w.y = cvt_pk_bf16(o0.z, o0.w); w.z = cvt_pk_bf16(o1.x, o1.y); w.w = cvt_pk_bf16(o1.z, o1.w);
                    *(u32x4*)(XB + (size_t)row * D + col0 + bj * 128) = w;
                }
                sq += __shfl_xor(sq, 16); sq += __shfl_xor(sq, 32);
                if (fq == 0) ssq[(size_t)row * 16 + u.pn * 4 + wc] = sq;
            }
            asm volatile("" ::: "memory");
        }
    }
};
struct EpiEvIn {
    static constexpr bool PERM = true;
    bf16_t* P; float* Z; const float* ssq;
    typedef RstdRaw Raw;
    __device__ __forceinline__ void pre_issue(const Unit& u, int wr, int fr, int fq, Raw& r) const { rstd_issue(ssq, u.pm, r); }
    __device__ __forceinline__ void pre_finish(const Raw& r, LAS float* dst, int wr, int wc, int fr, int fq) const { rstd_finish(r, dst); }
    __device__ __forceinline__ void operator()(const f32x4 (&acc)[2][2][4][2], const Unit& u, int wr, int wc, int fr, int fq, const LAS float* rl) const {
        const int row0 = u.pm * 256 + wr * 64 + fr, col0 = u.pn * 256 + wc * 32 + 8 * fq;
        const int pn = u.pn;
        float rsa[2][4];
#pragma unroll
        for (int ai = 0; ai < 2; ++ai)
#pragma unroll
            for (int m = 0; m < 4; ++m) rsa[ai][m] = rl[ai * 128 + wr * 64 + m * 16 + fr];
#pragma unroll
        for (int ai = 0; ai < 2; ++ai)
#pragma unroll
            for (int m = 0; m < 4; ++m) {
                const int row = row0 + ai * 128 + m * 16; const float rs = rsa[ai][m];
                if (pn == 10) {
                    if (wc == 0 && fq < 2) {
                        *(f32x4*)(Z + (size_t)row * 16 + 8 * fq) = acc[ai][0][m][0] * rs;
                        *(f32x4*)(Z + (size_t)row * 16 + 8 * fq + 4) = acc[ai][0][m][1] * rs;
                    }
                } else {
#pragma unroll
                    for (int bj = 0; bj < 2; ++bj) {
                        f32x2 X2[4];
#pragma unroll
                        for (int n = 0; n < 2; ++n) { const f32x4 a = acc[ai][bj][m][n] * rs; X2[2 * n] = (f32x2){a.x, a.y}; X2[2 * n + 1] = (f32x2){a.z, a.w}; }
                        if (pn == 0) {
#pragma unroll
                            for (int q = 0; q < 4; ++q) X2[q] = X2[q] * 0.125f;
                        } else if (pn >= 4) {
                            f32x2 E2[4];
#pragma unroll
                            for (int q = 0; q < 4; ++q) { f32x2 t = X2[q];
                                if (pn >= 6) t = t * ((t * t) * (0.044715f * 1.5957691216057308f) + 1.5957691216057308f);
                                t = t * (-1.4426950408889634f);
                                E2[q].x = __builtin_amdgcn_exp2f(t.x); E2[q].y = __builtin_amdgcn_exp2f(t.y); }
#pragma unroll
                            for (int q = 0; q < 4; ++q) { const f32x2 d = E2[q] + 1.0f; E2[q].x = __builtin_amdgcn_rcpf(d.x); E2[q].y = __builtin_amdgcn_rcpf(d.y); }
#pragma unroll
                            for (int q = 0; q < 4; ++q) X2[q] = X2[q] * E2[q];
                        }
                        u32x4 w; w.x = cvt_pk_bf16(X2[0].x, X2[0].y); w.y = cvt_pk_bf16(X2[1].x, X2[1].y); w.z = cvt_pk_bf16(X2[2].x, X2[2].y); w.w = cvt_pk_bf16(X2[3].x, X2[3].y);
                        st16_wt(P + (size_t)row * PEV_LD + col0 + bj * 128, w);
                    }
                }
            }
    }
};
struct EpiOdIn {
    static constexpr bool PERM = true;
    bf16_t* P; float* out; const float* ssq;
    typedef RstdRaw Raw;
    __device__ __forceinline__ void pre_issue(const Unit& u, int wr, int fr, int fq, Raw& r) const { rstd_issue(ssq, u.pm, r); }
    __device__ __forceinline__ void pre_finish(const Raw& r, LAS float* dst, int wr, int wc, int fr, int fq) const { rstd_finish(r, dst); }
    __device__ __forceinline__ void operator()(const f32x4 (&acc)[2][2][4][2], const Unit& u, int wr, int wc, int fr, int fq, const LAS float* rl) const {
        const int row0 = u.pm * 256 + wr * 64 + fr;
        const int pn = u.pn;
        float rsa[2][4];
#pragma unroll
        for (int ai = 0; ai < 2; ++ai)
#pragma unroll
            for (int m = 0; m < 4; ++m) rsa[ai][m] = rl[ai * 128 + wr * 64 + m * 16 + fr];
#pragma unroll
        for (int ai = 0; ai < 2; ++ai)
#pragma unroll
            for (int m = 0; m < 4; ++m) {
                const int row = row0 + ai * 128 + m * 16; const float rs = rsa[ai][m];
                const int t = row & 2047, b = row >> 11;
                if (pn < 4) {
                    const int col = pn * 128 + wc * 32 + 8 * fq;
                    float v[8];
                    {
                        const float cexp = -1.4426950408889634f * rs;
                        f32x2 E2[4], V2[4];
#pragma unroll
                        for (int n = 0; n < 2; ++n) { const f32x4 g = acc[ai][1][m][n] * cexp;
                            E2[2 * n].x = __builtin_amdgcn_exp2f(g.x); E2[2 * n].y = __builtin_amdgcn_exp2f(g.y); E2[2 * n + 1].x = __builtin_amdgcn_exp2f(g.z); E2[2 * n + 1].y = __builtin_amdgcn_exp2f(g.w); }
#pragma unroll
                        for (int q = 0; q < 4; ++q) { const f32x2 d = E2[q] + 1.0f; E2[q].x = __builtin_amdgcn_rcpf(d.x); E2[q].y = __builtin_amdgcn_rcpf(d.y); }
#pragma unroll
                        for (int n = 0; n < 2; ++n) { const f32x4 a = acc[ai][0][m][n] * rs; V2[2 * n] = (f32x2){a.x, a.y} * E2[2 * n]; V2[2 * n + 1] = (f32x2){a.z, a.w} * E2[2 * n + 1]; }
#pragma unroll
                        for (int q = 0; q < 4; ++q) { v[2 * q] = V2[q].x; v[2 * q + 1] = V2[q].y; }
                    }
                    u32x4 w; w.x = cvt_pk_bf16(v[0], v[1]); w.y = cvt_pk_bf16(v[2], v[3]); w.z = cvt_pk_bf16(v[4], v[5]); w.w = cvt_pk_bf16(v[6], v[7]);
                    *(u32x4*)(P + (size_t)row * POD_LD + col) = w;
                    float* o = nullptr;
                    if (row < MP) { if (t >= SEQ - 30) o = out + O_CONVP + ((size_t)(b * 30 + t - (SEQ - 30))) * 512 + col; }
                    else if (row < MT) o = out + O_CONVS + ((size_t)((row - MP) * 30 + 29)) * 512 + col;
                    if (o) { *(f32x4*)o = (f32x4){v[0], v[1], v[2], v[3]}; *(f32x4*)(o + 4) = (f32x4){v[4], v[5], v[6], v[7]}; }
                } else {
#pragma unroll
                    for (int bj = 0; bj < 2; ++bj) {
                        const int col = (pn - 4) * 256 + bj * 128 + wc * 32 + 8 * fq;
                        const f32x4 v0 = acc[ai][bj][m][0] * rs, v1 = acc[ai][bj][m][1] * rs;
                        u32x4 w; w.x = cvt_pk_bf16(v0.x, v0.y); w.y = cvt_pk_bf16(v0.z, v0.w); w.z = cvt_pk_bf16(v1.x, v1.y); w.w = cvt_pk_bf16(v1.z, v1.w);
                        *(u32x4*)(P + (size_t)row * POD_LD + 512 + col) = w;
                        float* o = nullptr;
                        if (row < MP) { if (t >= SEQ - 15) o = out + O_POOLP + ((size_t)(b * 15 + t - (SEQ - 15))) * 512 + col; }
                        else if (row < MT) o = out + O_POOLS + ((size_t)((row - MP) * 15 + 14)) * 512 + col;
                        if (o) { *(f32x4*)o = v0; *(f32x4*)(o + 4) = v1; }
                    }
                }
            }
    }
};
struct EpiPool {
    static constexpr bool PERM = true;
    bf16_t* MIX; const float* scale;
    __device__ __forceinline__ void operator()(const f32x4 (&acc)[2][2][4][2], const Unit& u, int wr, int wc, int fr, int fq) const {
        const int row0 = u.pm * 256 + wr * 64 + fr, col0 = u.pn * 256 + wc * 32 + 8 * fq;
#pragma unroll
        for (int bj = 0; bj < 2; ++bj) {
            const int col = col0 + bj * 128;
            const f32x4 s0 = *(const f32x4*)(scale + col), s1 = *(const f32x4*)(scale + col + 4);
#pragma unroll
            for (int ai = 0; ai < 2; ++ai)
#pragma unroll
                for (int m = 0; m < 4; ++m) {
                    const int row = row0 + ai * 128 + m * 16;
                    const f32x4 v0 = acc[ai][bj][m][0] * s0, v1 = acc[ai][bj][m][1] * s1;
                    u32x4 w; w.x = cvt_pk_bf16(v0.x, v0.y); w.y = cvt_pk_bf16(v0.z, v0.w); w.z = cvt_pk_bf16(v1.x, v1.y); w.w = cvt_pk_bf16(v1.z, v1.w);
                    *(u32x4*)(MIX + (size_t)row * D + 512 + col) = w;
                }
        }
    }
};

__device__ __forceinline__ int colmap(int mode, int n) {
    if (mode == 0) return n;
    if (mode == 1) { const int pn = n >> 8, j = n & 255; return j < 128 ? 128 * pn + j : 2816 + 128 * pn + (j - 128); }
    if (mode == 2) { return n < 1536 ? n : (n < 2560 ? n + 16 : (n < 2576 ? n - 1024 : -1)); }
    if (n < 1024) { const int pn = n >> 8, j = n & 255; return j < 128 ? 128 * pn + j : 512 + 128 * pn + (j - 128); }
    return n;
}
__device__ __forceinline__ void tr_item(const float* W, int ldw, int srccol4, const float* gain, bf16_t* dst, int K, LAS float* scr, int lane) {
    const int kl = lane >> 4, n4 = (lane & 15) * 4;
    f32x4 v[16];
#pragma unroll
    for (int i = 0; i < 16; ++i) { const int kk = 4 * i + kl; v[i] = (srccol4 >= 0) ? *(const f32x4*)(W + (size_t)kk * ldw + srccol4) : (f32x4){0.f, 0.f, 0.f, 0.f}; }
#pragma unroll
    for (int i = 0; i < 16; ++i) { const int kk = 4 * i + kl; f32x4 x = v[i]; if (gain) x *= gain[kk];
        LAS float* d = scr + kk * 65 + n4; d[0] = x.x; d[1] = x.y; d[2] = x.z; d[3] = x.w; }
    LDS_WAIT();
    const int c = lane & 7;
#pragma unroll
    for (int j = 0; j < 8; ++j) { const int n = (lane >> 3) + 8 * j; const LAS float* s = scr + (8 * c) * 65 + n;
        u32x4 o; o.x = cvt_pk_bf16(s[0 * 65], s[1 * 65]); o.y = cvt_pk_bf16(s[2 * 65], s[3 * 65]); o.z = cvt_pk_bf16(s[4 * 65], s[5 * 65]); o.w = cvt_pk_bf16(s[6 * 65], s[7 * 65]);
        st16_wt(dst + (size_t)(n) * K + 8 * c, o); }
    LDS_WAIT();
}
__device__ __forceinline__ void prep_one(const Params& p, int it, LAS float* scr, int lane) {
    const float* norm_g = p.in[5];
    const float* W; int K, Np, ldw, mode; const float* gain = nullptr; bf16_t* Bt; int r = it;
    if (r < 5632) { const int idx = r / 1408; r -= idx * 1408; const int l = idx >> 1, j = idx & 1;
        W = p.in[6] + (size_t)idx * 1024 * 5632; K = 1024; Np = 5632; ldw = 5632; mode = 1; gain = norm_g + (l * 3 + (j ? 2 : 0)) * 1024; Bt = (bf16_t*)(p.ws + WS_WFFIN) + (size_t)idx * 5632 * 1024; }
    else if (r < 8448) { r -= 5632; const int idx = r / 704; r -= idx * 704;
        W = p.in[7] + (size_t)idx * 2816 * 1024; K = 2816; Np = 1024; ldw = 1024; mode = 0; Bt = (bf16_t*)(p.ws + WS_WFFOUT) + (size_t)idx * 1024 * 2816; }
    else if (r < 9152) { r -= 8448; W = p.in[8]; K = 1024; Np = 2816; ldw = 2576; mode = 2; gain = norm_g + 1 * 1024; Bt = (bf16_t*)(p.ws + WS_WEVIN); }
    else if (r < 9408) { r -= 9152; W = p.in[16]; K = 1024; Np = 1024; ldw = 1024; mode = 0; Bt = (bf16_t*)(p.ws + WS_WEVOUT); }
    else if (r < 9792) { r -= 9408; W = p.in[17]; K = 1024; Np = 1536; ldw = 1536; mode = 3; gain = norm_g + 4 * 1024; Bt = (bf16_t*)(p.ws + WS_WODIN); }
    else if (r < 10048) { r -= 9792; W = p.in[24]; K = 1024; Np = 1024; ldw = 1024; mode = 0; Bt = (bf16_t*)(p.ws + WS_WODOUT); }
    else { r -= 10048; W = p.in[22]; K = 512; Np = 512; ldw = 128; mode = 4; Bt = (bf16_t*)(p.ws + WS_WPOOL); }
    const int nblk = Np / 64, kb = r / nblk, nb = r % nblk, k0 = 64 * kb, n0 = 64 * nb;
    int sc; const float* Wp;
    if (mode == 4) { const int gk = k0 >> 7, gn = n0 >> 7; sc = (gk == gn) ? (n0 & 127) + (lane & 15) * 4 : -1; Wp = W + (size_t)gk * 16384 + (size_t)(k0 & 127) * 128; }
    else { sc = colmap(mode, n0 + (lane & 15) * 4); Wp = W + (size_t)k0 * ldw; }
    tr_item(Wp, ldw, sc, gain ? gain + k0 : nullptr, Bt + (size_t)n0 * K + k0, K, scr, lane);
}
__device__ __forceinline__ void prep_range(const Params& p, LAS unsigned char* L, int lo, int hi, int wi, int nw) {
    const int lane = threadIdx.x & 63, wave = threadIdx.x >> 6;
    LAS float* scr = (LAS float*)(L + wave * 16640);
    for (int it = lo + wi; it < hi; it += nw) prep_one(p, it, scr, lane);
}
__device__ __forceinline__ void tail_prep(const Params& p, LAS unsigned char* L, int nwg, int lo1, int hi1, int lo2, int hi2) {
    const int G = gridDim.x, rem = nwg % G, bx = blockIdx.x, wave = threadIdx.x >> 6;
    int wi, nw;
    if (rem == 0) { wi = bx * 8 + wave; nw = G * 8; } else { if (bx < rem) return; wi = (bx - rem) * 8 + wave; nw = (G - rem) * 8; }
    prep_range(p, L, lo1, hi1, wi, nw);
    prep_range(p, L, lo2, hi2, wi, nw);
}
__device__ __forceinline__ void phase_prep(const Params& p, LAS unsigned char* L) {
    const int tid = threadIdx.x, lane = tid & 63, wave = tid >> 6;
    const int gw = blockIdx.x * 8 + wave, NGW = gridDim.x * 8;
    prep_range(p, L, 0, 1408, gw, NGW);
    bf16_t* XB = (bf16_t*)(p.ws + WS_XB); float* ssq = (float*)(p.ws + WS_SSQ);
    const int nslot = MPAD, G8 = gridDim.x >> 3;
    for (int sl = gw; sl < nslot; sl += NGW) {
        int row = sl;
        if ((gridDim.x & 7) == 0) { const int blk = sl >> 3, wv = sl & 7, xcd = blk & 7, ib = (blk % gridDim.x) >> 3, rnd = sl / NGW;
            const int r = rnd * (G8 * 8) + ib * 8 + wv;
            row = (r < 2048) ? xcd * 2048 + r : MP + (r - 2048) * 8 + xcd; if (r >= 2048 + 32) row = MPAD; }
        if (row >= MPAD) continue;
        float s = 0.f;
        if (row < MT) {
            const float* src = row < MP ? p.in[0] + (size_t)row * D : p.in[1] + (size_t)(row - MP) * D;
            f32x4 xv[4];
#pragma unroll
            for (int j = 0; j < 2; ++j) { xv[2 * j] = *(const f32x4*)(src + 8 * lane + 512 * j); xv[2 * j + 1] = *(const f32x4*)(src + 8 * lane + 512 * j + 4); }
#pragma unroll
            for (int j = 0; j < 2; ++j) { const f32x4 a = xv[2 * j], c = xv[2 * j + 1];
                s += ((a.x * a.x + a.y * a.y) + (a.z * a.z + a.w * a.w)) + ((c.x * c.x + c.y * c.y) + (c.z * c.z + c.w * c.w));
                u32x4 w; w.x = cvt_pk_bf16(a.x, a.y); w.y = cvt_pk_bf16(a.z, a.w); w.z = cvt_pk_bf16(c.x, c.y); w.w = cvt_pk_bf16(c.z, c.w);
                *(u32x4*)(XB + (size_t)row * D + 8 * lane + 512 * j) = w; }
            s = wave_sum(s);
        } else {
#pragma unroll
            for (int j = 0; j < 2; ++j) st16_wt(XB + (size_t)row * D + 8 * lane + 512 * j, (u32x4){0u, 0u, 0u, 0u});
        }
        if (lane < 16) ssq[(size_t)row * 16 + lane] = (lane == 0) ? s : 0.f;
    }
}

__device__ __forceinline__ void gla_cum(const Params& p, int h, int t0, LAS float* cum, LAS float* zs, LAS float* wgs, LAS float* bgs, LAS float* seg) {
    const int tid = threadIdx.x;
    const float* zb = (const float*)(p.ws + WS_Z);
    for (int i = tid; i < 1024; i += 512) zs[i] = zb[(size_t)t0 * 16 + i];
    for (int i = tid; i < 1024; i += 512) { const int r = i >> 6, k = i & 63; wgs[i] = p.in[9][r * 256 + h * 64 + k]; }
    if (tid < 64) bgs[tid] = p.in[10][h * 64 + tid];
    __syncthreads();
    const int kk = tid & 63, sg = tid >> 6;
    float wv[16];
#pragma unroll
    for (int r = 0; r < 16; ++r) wv[r] = wgs[r * 64 + kk];
    const float bb = bgs[kk];
    float run = 0.f, loc[8];
#pragma unroll
    for (int i = 0; i < 8; ++i) { const int s = sg * 8 + i; float g = bb;
#pragma unroll
        for (int r = 0; r < 16; ++r) g += zs[s * 16 + r] * wv[r];
        const float la = (fminf(g, 0.f) - __logf(1.f + __expf(-fabsf(g)))) * (1.f / 16.f);
        run += la; loc[i] = run; }
    seg[sg * 64 + kk] = run;
    __syncthreads();
    float off = 0.f;
#pragma unroll
    for (int j = 0; j < 8; ++j) if (j < sg) off += seg[j * 64 + kk];
#pragma unroll
    for (int i = 0; i < 8; ++i) cum[(sg * 8 + i) * 65 + kk] = off + loc[i];
    __syncthreads();
}
__device__ __forceinline__ f32x4 mma16(const LAS bf16_t* A, int pa, const LAS bf16_t* B, int pb, int ksteps, f32x4 acc, int fr, int fq) {
#pragma unroll
    for (int ks = 0; ks < ksteps; ++ks) {
        const bf16x8 a = *(const LAS bf16x8*)(A + fr * pa + ks * 32 + fq * 8);
        const bf16x8 b = *(const LAS bf16x8*)(B + fr * pb + ks * 32 + fq * 8);
        acc = __builtin_amdgcn_mfma_f32_16x16x32_bf16(a, b, acc, 0, 0, 0);
    }
    return acc;
}
constexpr int PT = 72;
__device__ __forceinline__ void stage_vt(const bf16_t* pev, int t0, int h, LAS bf16_t* Vt) {
    for (int i = threadIdx.x; i < 1024; i += 512) { const int sI = i >> 4, c8 = (i & 15) * 8;
        const u32x4 w = *(const u32x4*)(pev + (size_t)(t0 + sI) * PEV_LD + 512 + h * 128 + c8);
        const unsigned ww[4] = {w.x, w.y, w.z, w.w};
#pragma unroll
        for (int j = 0; j < 4; ++j) { Vt[(c8 + 2 * j) * PT + sI] = (bf16_t)(ww[j] & 0xffffu); Vt[(c8 + 2 * j + 1) * PT + sI] = (bf16_t)(ww[j] >> 16); } }
}
__device__ __forceinline__ void gla_a_item(const Params& p, LAS unsigned char* L, int item) {
    const int tid = threadIdx.x, wave = tid >> 6, lane = tid & 63, fr = lane & 15, fq = lane >> 4;
    const int b = item >> 7, h = (item >> 5) & 3, c = item & 31, t0 = b * SEQ + c * 64;
    LAS float* cum = (LAS float*)L; LAS bf16_t* Kt = (LAS bf16_t*)(cum + 4160); LAS bf16_t* Vt = Kt + 64 * PT;
    LAS float* zs = (LAS float*)(Vt + 128 * PT); LAS float* wgs = zs + 1024; LAS float* bgs = wgs + 1024; LAS float* seg = bgs + 64;
    gla_cum(p, h, t0, cum, zs, wgs, bgs, seg);
    const bf16_t* pev = (const bf16_t*)(p.ws + WS_H);
    {
        const int kk = tid & 63, sg = tid >> 6;
        const float last = cum[63 * 65 + kk];
        float* cb = (float*)(p.ws + WS_X) + (size_t)item * 4096;
        float kv[8];
#pragma unroll
        for (int i = 0; i < 8; ++i) { const int sI = sg * 8 + i; const float cm = cum[sI * 65 + kk]; cb[sI * 64 + kk] = cm;
            kv[i] = bf1(pev[(size_t)(t0 + sI) * PEV_LD + 256 + h * 64 + kk]) * __expf(last - cm); }
        u32x4 w; w.x = cvt_pk_bf16(kv[0], kv[1]); w.y = cvt_pk_bf16(kv[2], kv[3]); w.z = cvt_pk_bf16(kv[4], kv[5]); w.w = cvt_pk_bf16(kv[6], kv[7]);
        *(LAS u32x4*)(Kt + kk * PT + sg * 8) = w;
        if (tid < 64) ((float*)(p.ws + WS_DEC))[(size_t)item * 64 + tid] = __expf(last);
    }
    stage_vt(pev, t0, h, Vt);
    __syncthreads();
    float* KV = (float*)(p.ws + WS_KV) + (size_t)item * 8192;
#pragma unroll
    for (int kt = 0; kt < 4; ++kt) {
        const f32x4 acc = mma16(Kt + kt * 16 * PT, PT, Vt + wave * 16 * PT, PT, 2, (f32x4){0.f, 0.f, 0.f, 0.f}, fr, fq);
#pragma unroll
        for (int j = 0; j < 4; ++j) KV[(kt * 16 + fq * 4 + j) * 128 + wave * 16 + fr] = acc[j];
    }
    __syncthreads();
}
__device__ __forceinline__ void gla_scan_item(const Params& p, int item) {
    const int bh = item >> 4, e = (item & 15) * 512 + threadIdx.x, k = e >> 7;
    float* KV = (float*)(p.ws + WS_KV); const float* dec = (const float*)(p.ws + WS_DEC);
    float S = 0.f, kvv[32], dd[32];
#pragma unroll
    for (int c = 0; c < 32; ++c) { const size_t it = (size_t)bh * 32 + c; kvv[c] = KV[it * 8192 + e]; dd[c] = dec[it * 64 + k]; }
    bf16_t* Sb = (bf16_t*)(p.ws + WS_X + (16u << 20));
#pragma unroll
    for (int c = 0; c < 32; ++c) { const size_t it = (size_t)bh * 32 + c; Sb[it * 8192 + e] = (bf16_t)(cvt_pk_bf16(S, 0.f) & 0xffffu); S = dd[c] * S + kvv[c]; }
    p.out[O_GLAP + (size_t)bh * 8192 + e] = S;
}
__device__ __forceinline__ void gla_c_item(const Params& p, LAS unsigned char* L, int item) {
    const int tid = threadIdx.x, wave = tid >> 6, lane = tid & 63, fr = lane & 15, fq = lane >> 4;
    const int b = item >> 7, h = (item >> 5) & 3, c = item & 31, t0 = b * SEQ + c * 64;
    LAS bf16_t* Qs = (LAS bf16_t*)L; LAS bf16_t* Ks = Qs + 64 * PT; LAS bf16_t* Ps = Ks + 64 * PT; LAS bf16_t* Vt = Ps + 64 * PT; LAS bf16_t* St = Vt + 128 * PT;
    LAS float* Os = (LAS float*)Vt;
    const bf16_t* pev = (const bf16_t*)(p.ws + WS_H);
    const int vq8 = tid & 15, tq2 = tid >> 4;
    u32x4 rwv[2];
#pragma unroll
    for (int i = 0; i < 2; ++i) rwv[i] = *(const u32x4*)(pev + (size_t)(t0 + 2 * tq2 + i) * PEV_LD + 1024 + h * 128 + 8 * vq8);
    {
        const int sI = tid & 63, kg = tid >> 6;
        const u32x4 qw = *(const u32x4*)(pev + (size_t)(t0 + sI) * PEV_LD + h * 64 + kg * 8);
        const u32x4 kw = *(const u32x4*)(pev + (size_t)(t0 + sI) * PEV_LD + 256 + h * 64 + kg * 8);
        const float* cb = (const float*)(p.ws + WS_X) + (size_t)item * 4096 + sI * 64 + kg * 8;
        const f32x4 c0 = *(const f32x4*)cb, c1 = *(const f32x4*)(cb + 4);
        const float cm[8] = {c0.x, c0.y, c0.z, c0.w, c1.x, c1.y, c1.z, c1.w};
        const float qv[8] = {bf_lo(qw.x), bf_hi(qw.x), bf_lo(qw.y), bf_hi(qw.y), bf_lo(qw.z), bf_hi(qw.z), bf_lo(qw.w), bf_hi(qw.w)};
        const float kv[8] = {bf_lo(kw.x), bf_hi(kw.x), bf_lo(kw.y), bf_hi(kw.y), bf_lo(kw.z), bf_hi(kw.z), bf_lo(kw.w), bf_hi(kw.w)};
        float qe[8], ke[8];
#pragma unroll
        for (int i = 0; i < 8; ++i) { qe[i] = qv[i] * __expf(cm[i]); ke[i] = kv[i] * __expf(-cm[i]); }
        u32x4 w; w.x = cvt_pk_bf16(qe[0], qe[1]); w.y = cvt_pk_bf16(qe[2], qe[3]); w.z = cvt_pk_bf16(qe[4], qe[5]); w.w = cvt_pk_bf16(qe[6], qe[7]);
        *(LAS u32x4*)(Qs + sI * PT + kg * 8) = w;
        w.x = cvt_pk_bf16(ke[0], ke[1]); w.y = cvt_pk_bf16(ke[2], ke[3]); w.z = cvt_pk_bf16(ke[4], ke[5]); w.w = cvt_pk_bf16(ke[6], ke[7]);
        *(LAS u32x4*)(Ks + sI * PT + kg * 8) = w;
    }
    stage_vt(pev, t0, h, Vt);
    {
        const bf16_t* Sb = (const bf16_t*)(p.ws + WS_X + (16u << 20)) + (size_t)item * 8192;
        for (int i = tid; i < 1024; i += 512) { const int k = i >> 4, v8 = (i & 15) * 8; const u32x4 x = *(const u32x4*)(Sb + k * 128 + v8);
            const unsigned ww[4] = {x.x, x.y, x.z, x.w};
#pragma unroll
            for (int j = 0; j < 4; ++j) { St[(v8 + 2 * j) * PT + k] = (bf16_t)(ww[j] & 0xffffu); St[(v8 + 2 * j + 1) * PT + k] = (bf16_t)(ww[j] >> 16); } }
    }
    __syncthreads();
    {
        const int tt = wave >> 1;
#pragma unroll
        for (int si = 0; si < 2; ++si) { const int st = (wave & 1) * 2 + si;
            const f32x4 acc = mma16(Qs + tt * 16 * PT, PT, Ks + st * 16 * PT, PT, 2, (f32x4){0.f, 0.f, 0.f, 0.f}, fr, fq);
#pragma unroll
            for (int j = 0; j < 4; ++j) { const int t = tt * 16 + fq * 4 + j, sI = st * 16 + fr; const float v = (sI <= t) ? acc[j] : 0.f;
                Ps[t * PT + sI] = (bf16_t)(cvt_pk_bf16(v, 0.f) & 0xffffu); } }
    }
    __syncthreads();
    f32x4 oacc[4];
#pragma unroll
    for (int tt = 0; tt < 4; ++tt) {
        f32x4 a = mma16(Qs + tt * 16 * PT, PT, St + wave * 16 * PT, PT, 2, (f32x4){0.f, 0.f, 0.f, 0.f}, fr, fq);
        oacc[tt] = mma16(Ps + tt * 16 * PT, PT, Vt + wave * 16 * PT, PT, 2, a, fr, fq);
    }
    __syncthreads();
#pragma unroll
    for (int tt = 0; tt < 4; ++tt)
#pragma unroll
        for (int j = 0; j < 4; ++j) Os[(tt * 16 + fq * 4 + j) * 132 + wave * 16 + fr] = oacc[tt][j];
    __syncthreads();
    bf16_t* mix = (bf16_t*)(p.ws + WS_MIX);
    const f32x4 ga = *(const f32x4*)(p.in[11] + h * 128 + 8 * vq8), gb = *(const f32x4*)(p.in[11] + h * 128 + 8 * vq8 + 4);
#pragma unroll
    for (int i = 0; i < 2; ++i) {
        const int t = 2 * tq2 + i;
        const f32x4 a = *(const LAS f32x4*)(Os + t * 132 + 8 * vq8), c = *(const LAS f32x4*)(Os + t * 132 + 8 * vq8 + 4);
        float ss = ((a.x * a.x + a.y * a.y) + (a.z * a.z + a.w * a.w)) + ((c.x * c.x + c.y * c.y) + (c.z * c.z + c.w * c.w));
#pragma unroll
        for (int o = 1; o < 16; o <<= 1) ss += __shfl_xor(ss, o);
        const float rs = rsqrtf(ss * (1.f / 128.f) + EPS);
        const u32x4 rw = rwv[i];
        const f32x4 o0 = a * rs * ga * (f32x4){bf_lo(rw.x), bf_hi(rw.x), bf_lo(rw.y), bf_hi(rw.y)};
        const f32x4 o1 = c * rs * gb * (f32x4){bf_lo(rw.z), bf_hi(rw.z), bf_lo(rw.w), bf_hi(rw.w)};
        u32x4 w; w.x = cvt_pk_bf16(o0.x, o0.y); w.y = cvt_pk_bf16(o0.z, o0.w); w.z = cvt_pk_bf16(o1.x, o1.y); w.w = cvt_pk_bf16(o1.z, o1.w);
        st16_wt(mix + (size_t)(t0 + t) * D + h * 128 + 8 * vq8, w);
    }
    __syncthreads();
}
__device__ __forceinline__ void gla_s_item(const Params& p, LAS unsigned char* L, int item) {
    const int tid = threadIdx.x, seq = item >> 2, h = item & 3, row = MP + seq;
    LAS float* qs = (LAS float*)L; LAS float* ks = qs + 64; LAS float* ds = ks + 64; LAS float* po = ds + 64; LAS float* red = po + 512;
    const bf16_t* pev = (const bf16_t*)(p.ws + WS_H);
    if (tid < 64) {
        const float* z = (const float*)(p.ws + WS_Z) + (size_t)row * 16;
        float g = p.in[10][h * 64 + tid];
#pragma unroll
        for (int r = 0; r < 16; ++r) g += z[r] * p.in[9][r * 256 + h * 64 + tid];
        const float la = (fminf(g, 0.f) - log1pf(__expf(-fabsf(g)))) * (1.f / 16.f);
        ds[tid] = __expf(la);
        qs[tid] = bf1(pev[(size_t)row * PEV_LD + h * 64 + tid]);
        ks[tid] = bf1(pev[(size_t)row * PEV_LD + 256 + h * 64 + tid]);
    }
    __syncthreads();
    const int v = tid & 127, kq = tid >> 7;
    const float vv = bf1(pev[(size_t)row * PEV_LD + 512 + h * 128 + v]);
    const float* S0 = p.in[2] + (size_t)item * 8192; float* S1 = p.out + O_GLAS + (size_t)item * 8192;
    float o = 0.f;
    float s0v[16];
#pragma unroll
    for (int i = 0; i < 16; ++i) s0v[i] = S0[(kq * 16 + i) * 128 + v];
#pragma unroll
    for (int i = 0; i < 16; ++i) { const int k = kq * 16 + i; const float s0 = s0v[i]; const float d = ds[k]; o += qs[k] * d * s0; S1[k * 128 + v] = d * s0 + ks[k] * vv; }
    po[kq * 128 + v] = o;
    __syncthreads();
    float ot = 0.f;
    if (tid < 128) {
        float qk = 0.f;
#pragma unroll 8
        for (int k = 0; k < 64; ++k) qk += qs[k] * ks[k];
        ot = po[v] + po[128 + v] + po[256 + v] + po[384 + v] + qk * vv;
    }
    const float ss = wave_sum(ot * ot);
    if (tid < 128 && (tid & 63) == 0) red[tid >> 6] = ss;
    __syncthreads();
    if (tid < 128) {
        const float rs = rsqrtf((red[0] + red[1]) * (1.f / 128.f) + EPS);
        const float r = bf1(pev[(size_t)row * PEV_LD + 1024 + h * 128 + v]);
        const float ov = ot * rs * p.in[11][h * 128 + v] * r;
        ((bf16_t*)(p.ws + WS_MIX))[(size_t)row * D + h * 128 + v] = (bf16_t)(cvt_pk_bf16(ov, 0.f) & 0xffffu);
    }
    __syncthreads();
}

constexpr int PW = 136;
__device__ __forceinline__ void sg_item(const Params& p, LAS unsigned char* L, int item) {
    const int tid = threadIdx.x, wave = tid >> 6, lane = tid & 63, fr = lane & 15, fq = lane >> 4;
    const int h = item & 3, n = (item >> 2) & 15, b = item >> 6, t0 = b * SEQ + n * 128;
    LAS bf16_t* Wb = (LAS bf16_t*)L; LAS bf16_t* vT = Wb + 128 * PW; LAS float* mu = (LAS float*)(vT + 128 * PW); LAS float* rsd = mu + 128; LAS float* Os = rsd + 128;
    const bf16_t* pev = (const bf16_t*)(p.ws + WS_H);
    u32x4 vw[4], uwv[4]; float bv[4];
    {
        const int d8 = (tid & 15) * 8, sr = tid >> 4, tb = 4 * (tid >> 4);
#pragma unroll
        for (int ps = 0; ps < 4; ++ps) vw[ps] = *(const u32x4*)(pev + (size_t)(t0 + ps * 32 + sr) * PEV_LD + 2048 + h * 128 + d8);
#pragma unroll
        for (int i = 0; i < 4; ++i) { bv[i] = p.in[15][h * 128 + tb + i]; uwv[i] = *(const u32x4*)(pev + (size_t)(t0 + tb + i) * PEV_LD + 1536 + h * 128 + d8); }
    }
    {
        const int q = tid & 3, sI = tid >> 2;
        const bf16_t* src = pev + (size_t)(t0 + sI) * PEV_LD + 2048 + q * 128;
        float sm = 0.f, sq = 0.f;
#pragma unroll 4
        for (int i = 0; i < 16; ++i) { const u32x4 w = *(const u32x4*)(src + 8 * i);
            const float f[8] = {bf_lo(w.x), bf_hi(w.x), bf_lo(w.y), bf_hi(w.y), bf_lo(w.z), bf_hi(w.z), bf_lo(w.w), bf_hi(w.w)};
#pragma unroll
            for (int j = 0; j < 8; ++j) { sm += f[j]; sq += f[j] * f[j]; } }
        sm += __shfl_xor(sm, 1); sm += __shfl_xor(sm, 2); sq += __shfl_xor(sq, 1); sq += __shfl_xor(sq, 2);
        const float mean = sm * (1.f / 512.f), var = fmaxf(sq * (1.f / 512.f) - mean * mean, 0.f);
        if (q == 0) { mu[sI] = mean; rsd[sI] = rsqrtf(var + EPS); }
    }
    for (int i = tid; i < 2048; i += 512) {
        const int t = i >> 4, s8 = (i & 15) * 8;
        const float* wrow = p.in[14] + ((size_t)h * 128 + t) * 128 + s8;
        const f32x4 a = *(const f32x4*)wrow, c = *(const f32x4*)(wrow + 4);
        float f[8] = {a.x, a.y, a.z, a.w, c.x, c.y, c.z, c.w};
#pragma unroll
        for (int j = 0; j < 8; ++j) if (s8 + j > t) f[j] = 0.f;
        u32x4 w; w.x = cvt_pk_bf16(f[0], f[1]); w.y = cvt_pk_bf16(f[2], f[3]); w.z = cvt_pk_bf16(f[4], f[5]); w.w = cvt_pk_bf16(f[6], f[7]);
        *(LAS u32x4*)(Wb + t * PW + s8) = w;
    }
    __syncthreads();
    {
        const int d8 = (tid & 15) * 8, sr = tid >> 4;
        const f32x4 g0 = *(const f32x4*)(p.in[12] + h * 128 + d8), g1 = *(const f32x4*)(p.in[12] + h * 128 + d8 + 4);
        const f32x4 b0 = *(const f32x4*)(p.in[13] + h * 128 + d8), b1 = *(const f32x4*)(p.in[13] + h * 128 + d8 + 4);
#pragma unroll
        for (int ps = 0; ps < 4; ++ps) { const int sI = ps * 32 + sr;
            const u32x4 w = vw[ps];
            const float m = mu[sI], r = rsd[sI];
            const f32x4 x0 = ((f32x4){bf_lo(w.x), bf_hi(w.x), bf_lo(w.y), bf_hi(w.y)} - m) * r * g0 + b0;
            const f32x4 x1 = ((f32x4){bf_lo(w.z), bf_hi(w.z), bf_lo(w.w), bf_hi(w.w)} - m) * r * g1 + b1;
            if (n == 15) { float* o = p.out + O_SGVP + ((size_t)(b * 128 + sI)) * 512 + h * 128 + d8; *(f32x4*)o = x0; *(f32x4*)(o + 4) = x1; }
            const unsigned ww[4] = {cvt_pk_bf16(x0.x, x0.y), cvt_pk_bf16(x0.z, x0.w), cvt_pk_bf16(x1.x, x1.y), cvt_pk_bf16(x1.z, x1.w)};
#pragma unroll
            for (int j = 0; j < 4; ++j) { vT[(d8 + 2 * j) * PW + sI] = (bf16_t)(ww[j] & 0xffffu); vT[(d8 + 2 * j + 1) * PW + sI] = (bf16_t)(ww[j] >> 16); } }
    }
    __syncthreads();
#pragma unroll
    for (int tt = 0; tt < 8; ++tt) {
        const f32x4 acc = mma16(Wb + tt * 16 * PW, PW, vT + wave * 16 * PW, PW, tt / 2 + 1, (f32x4){0.f, 0.f, 0.f, 0.f}, fr, fq);
#pragma unroll
        for (int j = 0; j < 4; ++j) Os[(tt * 16 + fq * 4 + j) * 132 + wave * 16 + fr] = acc[j];
    }
    __syncthreads();
    {
        const int d0 = (tid & 15) * 8, tb = 4 * (tid >> 4);
        bf16_t* mix = (bf16_t*)(p.ws + WS_MIX);
#pragma unroll
        for (int i = 0; i < 4; ++i) { const int t = tb + i; const float bias = bv[i];
            const f32x4 a0 = *(const LAS f32x4*)(Os + t * 132 + d0), a1 = *(const LAS f32x4*)(Os + t * 132 + d0 + 4);
            const u32x4 uw = uwv[i];
            const f32x4 o0 = (a0 + bias) * (f32x4){bf_lo(uw.x), bf_hi(uw.x), bf_lo(uw.y), bf_hi(uw.y)};
            const f32x4 o1 = (a1 + bias) * (f32x4){bf_lo(uw.z), bf_hi(uw.z), bf_lo(uw.w), bf_hi(uw.w)};
            u32x4 w; w.x = cvt_pk_bf16(o0.x, o0.y); w.y = cvt_pk_bf16(o0.z, o0.w); w.z = cvt_pk_bf16(o1.x, o1.y); w.w = cvt_pk_bf16(o1.z, o1.w);
            st16_wt(mix + (size_t)(t0 + t) * D + 512 + h * 128 + d0, w); }
    }
    __syncthreads();
}
__device__ __forceinline__ void sg_s_row(const Params& p, int seq, int lane) {
    const int row = MP + seq, c0 = 8 * lane, h = c0 >> 7;
    const bf16_t* pev = (const bf16_t*)(p.ws + WS_H);
    const u32x4 w = *(const u32x4*)(pev + (size_t)row * PEV_LD + 2048 + c0);
    float f[8] = {bf_lo(w.x), bf_hi(w.x), bf_lo(w.y), bf_hi(w.y), bf_lo(w.z), bf_hi(w.z), bf_lo(w.w), bf_hi(w.w)};
    float sm = 0.f;
#pragma unroll
    for (int j = 0; j < 8; ++j) sm += f[j];
    const float mean = wave_sum(sm) * (1.f / 512.f);
    float sq = 0.f;
#pragma unroll
    for (int j = 0; j < 8; ++j) { f[j] -= mean; sq += f[j] * f[j]; }
    const float rs = rsqrtf(wave_sum(sq) * (1.f / 512.f) + EPS);
    const float w00 = p.in[14][(size_t)h * 16384], b0 = p.in[15][h * 128];
    const u32x4 uw = *(const u32x4*)(pev + (size_t)row * PEV_LD + 1536 + c0);
    const float uf[8] = {bf_lo(uw.x), bf_hi(uw.x), bf_lo(uw.y), bf_hi(uw.y), bf_lo(uw.z), bf_hi(uw.z), bf_lo(uw.w), bf_hi(uw.w)};
    float vnv[8], ov[8];
#pragma unroll
    for (int j = 0; j < 8; ++j) { vnv[j] = f[j] * rs * p.in[12][c0 + j] + p.in[13][c0 + j]; ov[j] = uf[j] * (w00 * vnv[j] + b0); }
    float* so = p.out + O_SGVS + (size_t)seq * 512 + c0;
    *(f32x4*)so = (f32x4){vnv[0], vnv[1], vnv[2], vnv[3]}; *(f32x4*)(so + 4) = (f32x4){vnv[4], vnv[5], vnv[6], vnv[7]};
    u32x4 o; o.x = cvt_pk_bf16(ov[0], ov[1]); o.y = cvt_pk_bf16(ov[2], ov[3]); o.z = cvt_pk_bf16(ov[4], ov[5]); o.w = cvt_pk_bf16(ov[6], ov[7]);
    st16_wt((bf16_t*)(p.ws + WS_MIX) + (size_t)row * D + 512 + c0, o);
}

__device__ __forceinline__ void conv_ln_rows(const Params& p, const LAS float* cout, int ntok, int rowbase, int wave, int lane) {
    const int c0 = 8 * lane;
    const f32x4 g0 = *(const f32x4*)(p.in[20] + c0), g1 = *(const f32x4*)(p.in[20] + c0 + 4);
    const f32x4 b0 = *(const f32x4*)(p.in[21] + c0), b1 = *(const f32x4*)(p.in[21] + c0 + 4);
#pragma unroll 4
    for (int t = wave; t < ntok; t += 8) {
        f32x4 x0 = *(const LAS f32x4*)(cout + t * 512 + c0), x1 = *(const LAS f32x4*)(cout + t * 512 + c0 + 4);
        float sm = (x0.x + x0.y) + (x0.z + x0.w) + (x1.x + x1.y) + (x1.z + x1.w);
        float sq = (x0.x * x0.x + x0.y * x0.y) + (x0.z * x0.z + x0.w * x0.w) + (x1.x * x1.x + x1.y * x1.y) + (x1.z * x1.z + x1.w * x1.w);
#pragma unroll
        for (int o = 1; o < 64; o <<= 1) { sm += __shfl_xor(sm, o); sq += __shfl_xor(sq, o); }
        const float mean = sm * (1.f / 512.f), var = fmaxf(sq * (1.f / 512.f) - mean * mean, 0.f);
        const float rs = rsqrtf(var + EPS);
        x0 = (x0 - mean) * rs * g0 + b0; x1 = (x1 - mean) * rs * g1 + b1;
        u32x4 w; w.x = cvt_pk_bf16(fsilu(x0.x), fsilu(x0.y)); w.y = cvt_pk_bf16(fsilu(x0.z), fsilu(x0.w)); w.z = cvt_pk_bf16(fsilu(x1.x), fsilu(x1.y)); w.w = cvt_pk_bf16(fsilu(x1.z), fsilu(x1.w));
        st16_wt((bf16_t*)(p.ws + WS_MIX) + (size_t)(rowbase + t) * D + c0, w);
    }
}
__device__ __forceinline__ void conv_item(const Params& p, LAS unsigned char* L, int item) {
    const int tid = threadIdx.x, b = item >> 6, tb = (item & 63) * 32;
    LAS unsigned* gin = (LAS unsigned*)L;
    LAS float* cout = (LAS float*)(L + 63488);
    const bf16_t* pod = (const bf16_t*)(p.ws + WS_H);
    {
        u32x4 wst[8];
#pragma unroll
        for (int k = 0; k < 8; ++k) { const int i = tid + 512 * k, r = i >> 6, c8 = (i & 63) * 8, t = tb - 30 + r;
            wst[k] = (u32x4){0u, 0u, 0u, 0u};
            if (i < 62 * 64 && t >= 0) wst[k] = *(const u32x4*)(pod + (size_t)(b * SEQ + t) * POD_LD + c8); }
#pragma unroll
        for (int k = 0; k < 8; ++k) { const int i = tid + 512 * k, r = i >> 6, c8 = (i & 63) * 8;
            if (i < 62 * 64) *(LAS u32x4*)(gin + r * 256 + (c8 >> 1)) = wst[k]; }
    }
    const int cp = tid & 255, half = tid >> 8;
    f32x2 w[31];
#pragma unroll
    for (int j = 0; j < 31; ++j) w[j] = *(const f32x2*)(p.in[18] + j * 512 + 2 * cp);
    const f32x2 bias = *(const f32x2*)(p.in[19] + 2 * cp);
    __syncthreads();
#pragma unroll 1
    for (int g = 0; g < 4; ++g) {
        const int tt = half * 16 + g * 4;
        f32x2 a[4];
#pragma unroll
        for (int i = 0; i < 4; ++i) a[i] = bias;
#pragma unroll
        for (int jj = 0; jj < 34; ++jj) { const unsigned x = gin[(tt + jj) * 256 + cp]; const f32x2 xv = (f32x2){bf_lo(x), bf_hi(x)};
#pragma unroll
            for (int i = 0; i < 4; ++i) { const int j = jj - i; if (j >= 0 && j <= 30) a[i] += w[j] * xv; } }
#pragma unroll
        for (int i = 0; i < 4; ++i) *(LAS f32x2*)(cout + (tt + i) * 512 + 2 * cp) = a[i];
    }
    __syncthreads();
    conv_ln_rows(p, cout, 32, b * SEQ + tb, tid >> 6, tid & 63);
    __syncthreads();
}
__device__ __forceinline__ void conv_s_item(const Params& p, LAS unsigned char* L, int seq) {
    const int c = threadIdx.x;
    LAS float* cout = (LAS float*)L;
    const bf16_t* pod = (const bf16_t*)(p.ws + WS_H);
    const float* st = p.in[3] + (size_t)seq * 30 * 512 + c; float* so = p.out + O_CONVS + (size_t)seq * 30 * 512 + c;
    float xs[30], wv[31];
#pragma unroll
    for (int j = 0; j < 30; ++j) { xs[j] = st[j * 512]; wv[j] = p.in[18][j * 512 + c]; }
    wv[30] = p.in[18][30 * 512 + c];
    float a = p.in[19][c] + wv[30] * bf1(pod[(size_t)(MP + seq) * POD_LD + c]);
#pragma unroll
    for (int j = 0; j < 30; ++j) a += wv[j] * xs[j];
#pragma unroll
    for (int j = 1; j < 30; ++j) so[(j - 1) * 512] = xs[j];
    cout[c] = a;
    __syncthreads();
    conv_ln_rows(p, cout, 1, MP + seq, threadIdx.x >> 6, threadIdx.x & 63);
    __syncthreads();
}
constexpr int PP = 520;
struct PoolB { bf16x8 b[4][4]; float sc[4]; };
__device__ __forceinline__ void pool_loadb(const Params& p, PoolB& B) {
    const int tid = threadIdx.x, wave = tid >> 6, lane = tid & 63, fr = lane & 15, fq = lane >> 4, g = wave >> 1;
    const bf16_t* Wp = (const bf16_t*)(p.ws + WS_WPOOL);
#pragma unroll
    for (int dt = 0; dt < 4; ++dt) { const int col = wave * 64 + dt * 16 + fr; B.sc[dt] = p.in[23][col];
#pragma unroll
        for (int ks = 0; ks < 4; ++ks) B.b[dt][ks] = *(const bf16x8*)(Wp + (size_t)col * 512 + g * 128 + ks * 32 + fq * 8); }
}
template <int NT>
__device__ __forceinline__ void pool_mma(const Params& p, const PoolB& B, const LAS bf16_t* Pd, LAS bf16_t* Ob, int rowbase) {
    const int tid = threadIdx.x, wave = tid >> 6, lane = tid & 63, fr = lane & 15, fq = lane >> 4, g = wave >> 1;
#pragma unroll
    for (int dt = 0; dt < 4; ++dt) {
        const int col = wave * 64 + dt * 16 + fr;
#pragma unroll
        for (int tt = 0; tt < NT / 16; ++tt) {
            f32x4 acc = (f32x4){0.f, 0.f, 0.f, 0.f};
#pragma unroll
            for (int ks = 0; ks < 4; ++ks) { const bf16x8 a = *(const LAS bf16x8*)(Pd + (tt * 16 + fr) * PP + g * 128 + ks * 32 + fq * 8);
                acc = __builtin_amdgcn_mfma_f32_16x16x32_bf16(a, B.b[dt][ks], acc, 0, 0, 0); }
            const unsigned w0 = cvt_pk_bf16(acc[0] * B.sc[dt], acc[1] * B.sc[dt]), w1 = cvt_pk_bf16(acc[2] * B.sc[dt], acc[3] * B.sc[dt]);
            LAS bf16_t* o = Ob + (tt * 16 + fq * 4) * PP + col;
            o[0] = (bf16_t)(w0 & 0xffffu); o[PP] = (bf16_t)(w0 >> 16); o[2 * PP] = (bf16_t)(w1 & 0xffffu); o[3 * PP] = (bf16_t)(w1 >> 16);
        }
    }
    __syncthreads();
    bf16_t* mix = (bf16_t*)(p.ws + WS_MIX);
    for (int i = tid; i < NT * 64; i += 512) { const int r = i >> 6, c8 = (i & 63) * 8;
        st16_wt(mix + (size_t)(rowbase + r) * D + 512 + c8, *(const LAS u32x4*)(Ob + r * PP + c8)); }
}
constexpr int PNT = 64;
template <int WIN>
__device__ __forceinline__ void pool_body(const bf16_t* base, LAS bf16_t* Pd, int tb) {
    float xv[WIN + PNT - 1];
#pragma unroll
    for (int i = 0; i < WIN + PNT - 1; ++i) { const int t = tb - (WIN - 1) + i; xv[i] = (t >= 0) ? bf1(base[(size_t)t * POD_LD]) : 0.f; }
    float s = 0.f;
#pragma unroll
    for (int i = 0; i < WIN - 1; ++i) s += xv[i];
#pragma unroll
    for (int tt = 0; tt < PNT; ++tt) { const float x = xv[WIN - 1 + tt]; s += x; const int t = tb + tt;
        const float inv = (t + 1 < WIN) ? 1.f / (float)(t + 1) : 1.f / (float)WIN;
        const float pv = s * inv - x;
        Pd[tt * PP] = (bf16_t)(cvt_pk_bf16(pv, 0.f) & 0xffffu);
        s -= xv[tt]; }
}
__device__ __forceinline__ void pool_item(const Params& p, LAS unsigned char* L, int item) {
    const int c = threadIdx.x, b = item >> 5, tb = (item & 31) * PNT, g = c >> 7;
    const bf16_t* base = (const bf16_t*)(p.ws + WS_H) + (size_t)(b * SEQ) * POD_LD + 512 + c;
    LAS bf16_t* Pd = (LAS bf16_t*)L; LAS bf16_t* Ob = Pd + PNT * PP;
    PoolB B; pool_loadb(p, B);
    if (g == 0) pool_body<2>(base, Pd + c, tb); else if (g == 1) pool_body<4>(base, Pd + c, tb); else if (g == 2) pool_body<8>(base, Pd + c, tb); else pool_body<16>(base, Pd + c, tb);
#if defined(PROBEP) && PROBEP == 1
    asm volatile("" ::: "memory");
    if (g == 0) pool_body<2>(base, Pd + c, tb); else if (g == 1) pool_body<4>(base, Pd + c, tb); else if (g == 2) pool_body<8>(base, Pd + c, tb); else pool_body<16>(base, Pd + c, tb);
#endif
    __syncthreads();
    pool_mma<PNT>(p, B, Pd, Ob, b * SEQ + tb);
    __syncthreads();
#if defined(PROBEP) && PROBEP == 2
    pool_mma<PNT>(p, B, Pd, Ob, b * SEQ + tb);
    __syncthreads();
#endif
}
__device__ __forceinline__ void pool_s_item(const Params& p, LAS unsigned char* L, int item) {
    const int c = threadIdx.x, win = 2 << (c >> 7);
    LAS bf16_t* Pd = (LAS bf16_t*)L; LAS bf16_t* Ob = Pd + 32 * PP;
    PoolB B; pool_loadb(p, B);
#pragma unroll 1
    for (int q0 = 0; q0 < 16; q0 += 4) {
        float sv[4][15], xq[4];
#pragma unroll
        for (int qq = 0; qq < 4; ++qq) { const int seq = item * 16 + q0 + qq; const float* st = p.in[4] + (size_t)seq * 15 * 512 + c;
            xq[qq] = bf1(((const bf16_t*)(p.ws + WS_H))[(size_t)(MP + seq) * POD_LD + 512 + c]);
#pragma unroll
            for (int j = 0; j < 15; ++j) sv[qq][j] = st[j * 512]; }
#pragma unroll
        for (int qq = 0; qq < 4; ++qq) { const int seq = item * 16 + q0 + qq; float* so = p.out + O_POOLS + (size_t)seq * 15 * 512 + c;
            float tot = xq[qq];
#pragma unroll
            for (int j = 0; j < 15; ++j) { if (j >= 1) so[(j - 1) * 512] = sv[qq][j]; if (15 - j <= win - 1) tot += sv[qq][j]; }
            const float pv = tot / (float)win - xq[qq];
            Pd[(q0 + qq) * PP + c] = (bf16_t)(cvt_pk_bf16(pv, 0.f) & 0xffffu); }
    }
    __syncthreads();
    pool_mma<16>(p, B, Pd, Ob, MP + item * 16);
    __syncthreads();
}

__device__ __forceinline__ void skinny_resid_item(const Params& p, LAS unsigned char* L, const bf16_t* A, const bf16_t* Bt, int K, float scale, const float* xin_s  , int item) {
    const int tid = threadIdx.x, wave = tid >> 6, lane = tid & 63, fr = lane & 15, fq = lane >> 4;
    const int rg = item & 7, cgp = item >> 3;
    const int kw = K >> 3, ksteps = kw >> 5;
    const bf16_t* ap = A + (size_t)(rg * 16 + fr) * K + wave * kw + fq * 8;
    const bf16_t* bp = Bt + (size_t)(cgp * 64 + fr) * K + wave * kw + fq * 8;
    f32x4 acc[4];
#pragma unroll
    for (int n = 0; n < 4; ++n) acc[n] = (f32x4){0.f, 0.f, 0.f, 0.f};
#pragma unroll 6
    for (int ks = 0; ks < ksteps; ++ks) {
        const bf16x8 a = *(const bf16x8*)(ap + ks * 32);
#pragma unroll
        for (int n = 0; n < 4; ++n) { const bf16x8 b = *(const bf16x8*)(bp + (size_t)n * 16 * K + ks * 32); acc[n] = __builtin_amdgcn_mfma_f32_16x16x32_bf16(a, b, acc[n], 0, 0, 0); }
    }
    LAS float* red = (LAS float*)L;
#pragma unroll
    for (int n = 0; n < 4; ++n)
#pragma unroll
        for (int j = 0; j < 4; ++j) red[wave * 1024 + (fq * 4 + j) * 64 + n * 16 + fr] = acc[n][j];
    __syncthreads();
    const int o = tid * 2, r = o >> 6, c = o & 63;
    float s0 = 0.f, s1 = 0.f;
#pragma unroll
    for (int w = 0; w < 8; ++w) { const f32x2 v = *(const LAS f32x2*)(red + w * 1024 + o); s0 += v.x; s1 += v.y; }
    const int lrow = rg * 16 + r, row = MP + lrow, col = cgp * 64 + c;
    unsigned* xbp = (unsigned*)((bf16_t*)(p.ws + WS_XB) + (size_t)row * D + col);
    f32x2 xi;
    if (xin_s) xi = *(const f32x2*)(xin_s + (size_t)lrow * D + col); else { const unsigned w = *xbp; xi = (f32x2){bf_lo(w), bf_hi(w)}; }
    const float x0 = xi.x + scale * s0, x1 = xi.y + scale * s1;
    *xbp = cvt_pk_bf16(x0, x1);
    float sq = x0 * x0 + x1 * x1;
#pragma unroll
    for (int of = 1; of < 32; of <<= 1) sq += __shfl_xor(sq, of);
    if ((tid & 31) == 0) ((float*)(p.ws + WS_SSQ))[(size_t)row * 16 + cgp] = sq;
    __syncthreads();
}

#define XB_TMO      128
#define XB_XCNT(j)  (256  + 64 * (j))
#define XB_XSUB(j)  (1280 + 64 * (j))
#define XB_XGEN(j)  (2304 + 64 * (j))
#define XB_TOP      3328
#define XB_TOPGEN   3392
#define XCD_BAR_WORDS 3456
#define XB_SPIN_CAP (1u << 20)
__device__ __forceinline__ unsigned xb_ld(unsigned* p)              { return __hip_atomic_load(p, __ATOMIC_RELAXED, __HIP_MEMORY_SCOPE_AGENT); }
__device__ __forceinline__ unsigned xb_add(unsigned* p, unsigned v) { return __hip_atomic_fetch_add(p, v, __ATOMIC_RELAXED, __HIP_MEMORY_SCOPE_AGENT); }
__device__ __forceinline__ unsigned xb_xcc_id() { return (unsigned)__builtin_amdgcn_s_getreg((3 << 11) | 20) & 0xFu; }
#define XB_SPIN(cond, bar) do { unsigned _sp = 0; while (cond) { __builtin_amdgcn_s_sleep(1); \
    if ((++_sp & 255u) == 0u) { if (xb_ld(&(bar)[XB_TMO])) break; if (_sp > XB_SPIN_CAP) { atomicAdd(&(bar)[XB_TMO], 1u); break; } } } } while (0)
struct XcdBarrier { unsigned* bar; unsigned x; volatile LAS unsigned* st; };
__device__ __forceinline__ XcdBarrier xcd_barrier_post(unsigned* bar, volatile LAS unsigned* st) {
    XcdBarrier b; b.bar = bar; b.x = xb_xcc_id(); b.st = st;
    if (threadIdx.x == 0) (void)xb_add(&bar[XB_XCNT(b.x)], 1u);
    return b;
}
__device__ __forceinline__ void xcd_barrier_complete(unsigned* bar, unsigned x, unsigned& nloc, unsigned& nx) {
    const unsigned G = gridDim.x * gridDim.y * gridDim.z;
    unsigned sum, cnt, mine, sp = 0u;
    for (;;) {
        sum = 0u; cnt = 0u; mine = 0u;
#pragma unroll
        for (unsigned j = 0; j < 16; ++j) { const unsigned c = xb_ld(&bar[XB_XCNT(j)]); sum += c; cnt += (c > 0u) ? 1u : 0u; mine = (j == x) ? c : mine; }
        if (sum == G) break;
        __builtin_amdgcn_s_sleep(1);
        if ((++sp & 255u) == 0u) { if (xb_ld(&bar[XB_TMO])) break; if (sp > XB_SPIN_CAP) { atomicAdd(&bar[XB_TMO], 1u); break; } }
    }
    nloc = mine > 0u ? mine : 1u; nx = cnt > 0u ? cnt : 1u;
}
__device__ __forceinline__ void xcd_barrier(const XcdBarrier& b) {
    asm volatile("s_waitcnt vmcnt(0)" ::: "memory");
    __syncthreads();
    if (threadIdx.x == 0) {
        unsigned* bar = b.bar;
        __builtin_amdgcn_s_waitcnt(0);
        unsigned nloc = b.st[0], nx = b.st[1];
        if (nloc == 0u) { xcd_barrier_complete(bar, b.x, nloc, nx); b.st[0] = nloc; b.st[1] = nx; }
        const unsigned old = xb_add(&bar[XB_XSUB(b.x)], 1u);
        const unsigned gen = old / nloc;
        if (old + 1u == (gen + 1u) * nloc) {
            __builtin_amdgcn_fence(__ATOMIC_RELEASE, "agent");
            asm volatile("s_waitcnt vmcnt(0)" ::: "memory");
            const unsigned og = xb_add(&bar[XB_TOP], 1u);
            const unsigned tg = og / nx;
            if (og + 1u == (tg + 1u) * nx) xb_add(&bar[XB_TOPGEN], 1u);
            else XB_SPIN(xb_ld(&bar[XB_TOPGEN]) == tg, bar);
            __builtin_amdgcn_fence(__ATOMIC_ACQUIRE, "agent");
            xb_add(&bar[XB_XGEN(b.x)], 1u);
            asm volatile("s_waitcnt vmcnt(0)" ::: "memory");
        } else {
            XB_SPIN(xb_ld(&bar[XB_XGEN(b.x)]) == gen, bar);
            __builtin_amdgcn_fence(__ATOMIC_ACQUIRE, "agent");
            asm volatile("s_waitcnt vmcnt(0)" ::: "memory");
        }
    }
    __syncthreads();
}

__device__ __forceinline__ void ffn_in_phase(const Params& p, LAS unsigned char* L, int idx, int lo1, int hi1, int lo2, int hi2) {
    pg8::Gemm g{(const bf16_t*)(p.ws + WS_XB), (const bf16_t*)(p.ws + WS_WFFIN) + (size_t)idx * 5632 * 1024, MPAD, 5632, 1024};
    pg8::StaticOrder S; S.init(MPAD, 5632, gridDim.x, blockIdx.x);
    EpiFfnIn E{(bf16_t*)(p.ws + WS_H), (const float*)(p.ws + WS_SSQ)};
    pg8::gemm_phase<EpiFfnIn>(L, g, S, E);
    tail_prep(p, L, (MPAD / 256) * 22, lo1, hi1, lo2, hi2);
}
template <bool FIRST>
__device__ __forceinline__ void resid_phase(const Params& p, LAS unsigned char* L, const bf16_t* A, const bf16_t* Bt, int K, float scale) {
    pg8::Gemm g{A, Bt, MP, 1024, K};
    pg8::StaticOrder S; S.init(MP, 1024, gridDim.x, blockIdx.x);
    if (p.dry) scale = 0.f;
    EpiResid<FIRST> E{p.in[0], (bf16_t*)(p.ws + WS_XB), (float*)(p.ws + WS_SSQ), scale};
    pg8::gemm_phase<EpiResid<FIRST>>(L, g, S, E);
    for (int it = (int)gridDim.x - 1 - (int)blockIdx.x; it < 128; it += gridDim.x) skinny_resid_item(p, L, A + (size_t)MP * K, Bt, K, scale, FIRST ? p.in[1] : nullptr, it);
}

__global__ void __launch_bounds__(512, 2) mk_fwd(Params p) {
    extern __shared__ __attribute__((aligned(16))) unsigned char lds_raw[];
    LAS unsigned char* L = (LAS unsigned char*)lds_raw;
    const int tid = threadIdx.x, G = gridDim.x, bx = blockIdx.x;
    const int lo = p.ph_lo, hi = p.ph_hi;
    int ph = 0;
#if MK_MULTI
#define SEAM() do { ++ph; } while (0)
#else
    if (tid < 4) ((LAS unsigned*)(L + LDS_BYTES - 16))[tid] = 0u;
    __syncthreads();
    const XcdBarrier xbar = xcd_barrier_post((unsigned*)(p.ws + WS_BAR), (volatile LAS unsigned*)(L + LDS_BYTES - 16));
    if (p.ph_hi < 0) cg::this_grid().sync();
#define SEAM() do { ++ph; xcd_barrier(xbar); } while (0)
#endif
#define IN() (lo <= ph && ph < hi)
    const bf16_t* XB = (const bf16_t*)(p.ws + WS_XB);
    const bf16_t* Hb = (const bf16_t*)(p.ws + WS_H);
    const bf16_t* MIX = (const bf16_t*)(p.ws + WS_MIX);
    const bf16_t* WFFOUT = (const bf16_t*)(p.ws + WS_WFFOUT);

    if (IN()) phase_prep(p, L);
    SEAM();
    if (IN()) ffn_in_phase(p, L, 0, 5632, 6336, 8448, 9408);
    SEAM();
    if (IN()) resid_phase<true>(p, L, Hb, WFFOUT, DFF, 0.5f);
    SEAM();
    if (IN()) {
        pg8::Gemm g{XB, (const bf16_t*)(p.ws + WS_WEVIN), MPAD, EVN, 1024};
        pg8::StaticOrder S; S.init(MPAD, EVN, G, bx);
        EpiEvIn E{(bf16_t*)(p.ws + WS_H), (float*)(p.ws + WS_Z), (const float*)(p.ws + WS_SSQ)};
        pg8::gemm_phase<EpiEvIn>(L, g, S, E);
        tail_prep(p, L, (MPAD / 256) * 11, 1408, 2816, 0, 0);
    }
    SEAM();
    if (IN()) {
        for (int it = bx; it < 1024; it += G) gla_a_item(p, L, it);
        for (int sl = bx; sl < 512; sl += G) sg_item(p, L, (G & 7) ? sl : (sl & 7) * 64 + (sl >> 3));
        for (int s = bx * 8 + (tid >> 6); s < NS; s += G * 8) sg_s_row(p, s, tid & 63);
    }
    SEAM();
    if (IN()) { for (int it = bx; it < 512; it += G) gla_scan_item(p, it); }
    SEAM();
    if (IN()) {
        for (int it = bx; it < 1024; it += G) gla_c_item(p, L, it);
        for (int it = bx; it < 512; it += G) gla_s_item(p, L, it);
    }
    SEAM();
    if (IN()) resid_phase<false>(p, L, MIX, (const bf16_t*)(p.ws + WS_WEVOUT), 1024, 1.0f);
    SEAM();
    if (IN()) ffn_in_phase(p, L, 1, 6336, 7040, 2816, 4224);
    SEAM();
    if (IN()) resid_phase<false>(p, L, Hb, WFFOUT + (size_t)1 * 1024 * 2816, DFF, 0.5f);
    SEAM();
    if (IN()) ffn_in_phase(p, L, 2, 7040, 7744, 9408, 10112);
    SEAM();
    if (IN()) resid_phase<false>(p, L, Hb, WFFOUT + (size_t)2 * 1024 * 2816, DFF, 0.5f);
    SEAM();
    if (IN()) {
        pg8::Gemm g{XB, (const bf16_t*)(p.ws + WS_WODIN), MPAD, ODN, 1024};
        pg8::StaticOrder S; S.init(MPAD, ODN, G, bx);
        EpiOdIn E{(bf16_t*)(p.ws + WS_H), p.out, (const float*)(p.ws + WS_SSQ)};
        pg8::gemm_phase<EpiOdIn>(L, g, S, E);
        tail_prep(p, L, (MPAD / 256) * 6, 4224, 5632, 0, 0);
    }
    SEAM();
    if (IN()) {
        for (int sl = bx; sl < 512; sl += G) conv_item(p, L, (G & 7) ? sl : (sl & 7) * 64 + (sl >> 3));
#if defined(PROBE13) && PROBE13 == 1
        for (int it = bx; it < 512; it += G) conv_item(p, L, it);
#endif
        for (int it = bx; it < NS; it += G) conv_s_item(p, L, it);
#if defined(PROBE13) && PROBE13 == 3
        for (int it = bx; it < NS; it += G) conv_s_item(p, L, it);
#endif
        for (int sl = bx; sl < 256; sl += G) pool_item(p, L, (G & 7) ? sl : (sl & 7) * 32 + (sl >> 3));
        for (int it = G - 1 - bx; it < 8; it += G) pool_s_item(p, L, it);
    }
    SEAM();
    if (IN()) resid_phase<false>(p, L, MIX, (const bf16_t*)(p.ws + WS_WODOUT), 1024, 1.0f);
    SEAM();
    if (IN()) ffn_in_phase(p, L, 3, 7744, 8448, 0, 0);
    SEAM();
    if (IN()) resid_phase<false>(p, L, Hb, WFFOUT + (size_t)3 * 1024 * 2816, DFF, 0.5f);
    SEAM();
    if (IN()) {
        const int lane = tid & 63; const float* ssq = (const float*)(p.ws + WS_SSQ);
        const f32x4 g0[2] = {*(const f32x4*)(p.in[25] + 8 * lane), *(const f32x4*)(p.in[25] + 8 * lane + 512)};
        const f32x4 g1[2] = {*(const f32x4*)(p.in[25] + 8 * lane + 4), *(const f32x4*)(p.in[25] + 8 * lane + 516)};
        for (int row = bx * 8 + (tid >> 6); row < MT; row += 2 * G * 8) {
            const int row2 = row + G * 8; const bool has2 = row2 < MT; const int r2 = has2 ? row2 : row;
            u32x4 w[2][2]; f32x4 sq[2];
#pragma unroll
            for (int j = 0; j < 2; ++j) { w[0][j] = *(const u32x4*)(XB + (size_t)row * D + 8 * lane + 512 * j); w[1][j] = *(const u32x4*)(XB + (size_t)r2 * D + 8 * lane + 512 * j); }
            sq[0] = *(const f32x4*)(ssq + (size_t)row * 16 + 4 * (lane & 3)); sq[1] = *(const f32x4*)(ssq + (size_t)r2 * 16 + 4 * (lane & 3));
#pragma unroll
            for (int q = 0; q < 2; ++q) {
                float t = (sq[q].x + sq[q].y) + (sq[q].z + sq[q].w); t += __shfl_xor(t, 1); t += __shfl_xor(t, 2);
                const float rs = rsqrtf(t * (1.f / 1024.f) + EPS);
                if (q == 0 || has2) {
                    float* o = p.out + O_Y + (size_t)(q ? r2 : row) * D + 8 * lane;
#pragma unroll
                    for (int j = 0; j < 2; ++j) { const u32x4 x = w[q][j];
                        *(f32x4*)(o + 512 * j) = (f32x4){bf_lo(x.x), bf_hi(x.x), bf_lo(x.y), bf_hi(x.y)} * rs * g0[j];
                        *(f32x4*)(o + 512 * j + 4) = (f32x4){bf_lo(x.z), bf_hi(x.z), bf_lo(x.w), bf_hi(x.w)} * rs * g1[j]; }
                }
            }
        }
    }
#undef IN
#undef SEAM
}
constexpr int N_PHASES = 18;

extern "C" void kernel_launch(void* const* d_in, const int* in_sizes, int n_in, void* d_out, int out_size, void* d_ws, size_t ws_size, hipStream_t stream) {
    static int grid = 0;
    if (grid == 0) {
        if (n_in != 26 || ws_size < WS_END) { fprintf(stderr, "kernel_launch: unexpected n_in %d / ws_size %zu (need %zu)\n", n_in, ws_size, (size_t)WS_END); grid = -1; return; }
        int dev = 0, cus = 0, per_cu = 0;
        hipGetDevice(&dev);
        hipDeviceGetAttribute(&cus, hipDeviceAttributeMultiprocessorCount, dev);
        if (hipFuncSetAttribute((const void*)mk_fwd, hipFuncAttributeMaxDynamicSharedMemorySize, LDS_BYTES) != hipSuccess) { fprintf(stderr, "kernel_launch: hipFuncSetAttribute failed\n"); grid = -1; return; }
        if (hipOccupancyMaxActiveBlocksPerMultiprocessor(&per_cu, (const void*)mk_fwd, 512, LDS_BYTES) != hipSuccess || per_cu < 1) { fprintf(stderr, "kernel_launch: occupancy query gave %d\n", per_cu); per_cu = 1; }
        (void)hipGetLastError();
        grid = cus * per_cu;
        fprintf(stderr, "kernel_launch: grid %d (cus %d x %d)\n", grid, cus, per_cu);
    }
    if (grid < 0) return;
    Params p{};
    for (int i = 0; i < 26; ++i) p.in[i] = (const float*)d_in[i];
    p.out = (float*)d_out; p.ws = (unsigned char*)d_ws;
#if MK_MULTI
    for (int ph = 0; ph < N_PHASES; ++ph) {
        int reps = 1;
#ifdef PROBE_EXTRA
        { const int ex[] = PROBE_EXTRA; for (unsigned i = 0; i < sizeof(ex) / sizeof(int); ++i) if (ex[i] == ph) ++reps; }
#endif
        for (int r = 0; r < reps; ++r) { p.ph_lo = ph; p.ph_hi = ph + 1; p.dry = r; hipLaunchKernelGGL(mk_fwd, dim3(grid), dim3(512), LDS_BYTES, stream, p); }
    }
#else
    p.ph_lo = 0; p.ph_hi = N_PHASES;
    if (hipMemsetAsync((char*)d_ws + WS_BAR, 0, XCD_BAR_WORDS * 4, stream) != hipSuccess) { fprintf(stderr, "kernel_launch: memset failed\n"); return; }
    void* args[] = {&p};
    hipError_t e = hipLaunchCooperativeKernel((const void*)mk_fwd, dim3(grid), dim3(512), args, LDS_BYTES, stream);
    if (e != hipSuccess) fprintf(stderr, "kernel_launch: cooperative launch failed: %s (grid %d)\n", hipGetErrorString(e), grid);
#endif
}
```
